# Optimizing an MI355X kernel written in HIP

```python
import jax, jax.numpy as jnp
from jax import lax
import numpy as np

D_MODEL = 1024
BATCH = 8
SEQ = 2048
DEPTH = 1
DEC_BATCH = 32
DEC_SEQ = 32
PAST_LEN = 4096

CHUNK = 64
D_CONV = D_MODEL
D_POOL = D_MODEL
CONV_W = 3
POOL_WINDOWS = (2, 4, 8, 16)
N_POOL_GROUPS = len(POOL_WINDOWS)
POOL_GW = D_POOL // N_POOL_GROUPS
POOL_HIST = max(POOL_WINDOWS) - 1
PLE_DIM = 256
N_IN_COLS = 4 * D_CONV + 2 * D_POOL + 2 * D_MODEL
EPS = 1e-6

kernel_name = "gated_conv_pool_streaming_encoder_step"


def _rmsnorm(x, g):
    xf = x.astype(jnp.float32)
    y = xf * lax.rsqrt(jnp.mean(xf * xf, axis=-1, keepdims=True) + EPS)
    return (y * g.astype(jnp.float32)).astype(x.dtype)


def _layer(x, p, conv_hist, pool_hist, offset, g_pre, w_in, conv_w, conv_b, w_grp,
           pool_scale, w_a_out, w_b_out, w_o, g_post, w_ple, w_pgate):
    b, L, _ = x.shape
    h = _rmsnorm(x, g_pre)
    proj = h @ w_in
    sizes = [D_CONV, D_CONV, D_CONV, D_CONV, D_POOL, D_POOL, D_MODEL, D_MODEL]
    cuts = list(np.cumsum(sizes)[:-1])
    xa, ba, ca, za, xb, zb, ga, gb = jnp.split(proj, cuts, axis=-1)

    u = ca * xa
    up = jnp.concatenate([conv_hist.astype(u.dtype), u], axis=1)
    conv = conv_b + sum(conv_w[k] * up[:, k:k + L] for k in range(CONV_W))
    ya = ((ba * conv) * jax.nn.silu(za)) @ w_a_out
    new_conv = up[:, -(CONV_W - 1):]

    bp = jnp.concatenate([pool_hist.astype(xb.dtype), xb], axis=1)
    cs = jnp.cumsum(bp.astype(jnp.float32), axis=1)
    cs0 = jnp.concatenate([jnp.zeros((b, 1, D_POOL), jnp.float32), cs], axis=1)
    pos = offset + jnp.arange(L)
    start = POOL_HIST + 1
    pooled = []
    for g, w in enumerate(POOL_WINDOWS):
        sl = slice(g * POOL_GW, (g + 1) * POOL_GW)
        s = cs0[:, start:, sl] - cs0[:, start - w:start - w + L, sl]
        cnt = jnp.minimum(pos + 1, w).astype(jnp.float32)
        pooled.append(s / cnt[None, :, None])
    pooled = jnp.concatenate(pooled, axis=-1)
    d = (pooled - xb.astype(jnp.float32)).astype(xb.dtype).reshape(b, L, N_POOL_GROUPS, POOL_GW)
    mixed = jnp.einsum('blgc,gcd->blgd', d, w_grp).reshape(b, L, D_POOL) * pool_scale
    yb = (mixed * jax.nn.silu(zb)) @ w_b_out
    new_pool = bp[:, -POOL_HIST:]

    m = jax.nn.sigmoid(ga) * ya + jax.nn.sigmoid(gb) * yb
    o = m @ w_o
    x1 = x + _rmsnorm(o, g_post)

    e = (p @ w_ple) * jax.nn.sigmoid(x1 @ w_pgate)
    return x1 + e, new_conv, new_pool


def setup_inputs(seed: int = 0) -> dict:
    key = jax.random.key(seed)
    ks = jax.random.split(key, 20)
    f32 = jnp.float32
    nrm = lambda k, shape, scale: jax.random.normal(k, shape, f32) * scale
    return {
        "x_prompt": nrm(ks[0], (BATCH, SEQ, D_MODEL), 1.0),
        "x_sample": nrm(ks[1], (DEC_BATCH, DEC_SEQ, D_MODEL), 1.0),
        "p_prompt": nrm(ks[2], (DEPTH, BATCH, SEQ, PLE_DIM), 1.0),
        "p_sample": nrm(ks[3], (DEPTH, DEC_BATCH, DEC_SEQ, PLE_DIM), 1.0),
        "cache_conv": nrm(ks[4], (DEPTH, DEC_BATCH, CONV_W - 1, D_CONV), 1.0),
        "state_pool": nrm(ks[5], (DEPTH, DEC_BATCH, POOL_HIST, D_POOL), 1.0),
        "g_pre": 1.0 + nrm(ks[6], (DEPTH, D_MODEL), 0.05),
        "w_in": nrm(ks[7], (DEPTH, D_MODEL, N_IN_COLS), D_MODEL ** -0.5),
        "conv_w": nrm(ks[8], (DEPTH, CONV_W, D_CONV), CONV_W ** -0.5),
        "conv_b": nrm(ks[9], (DEPTH, D_CONV), 0.02),
        "w_grp": nrm(ks[10], (DEPTH, N_POOL_GROUPS, POOL_GW, POOL_GW), POOL_GW ** -0.5),
        "pool_scale": 1.0 + nrm(ks[11], (DEPTH, D_POOL), 0.05),
        "w_a_out": nrm(ks[12], (DEPTH, D_CONV, D_MODEL), D_CONV ** -0.5),
        "w_b_out": nrm(ks[13], (DEPTH, D_POOL, D_MODEL), D_POOL ** -0.5),
        "w_o": nrm(ks[14], (DEPTH, D_MODEL, D_MODEL), D_MODEL ** -0.5),
        "g_post": 1.0 + nrm(ks[15], (DEPTH, D_MODEL), 0.05),
        "w_ple": nrm(ks[16], (DEPTH, PLE_DIM, D_MODEL), PLE_DIM ** -0.5),
        "w_pgate": nrm(ks[17], (DEPTH, D_MODEL, D_MODEL), D_MODEL ** -0.5),
    }


def reference(x_prompt, x_sample, p_prompt, p_sample, cache_conv, state_pool,
              g_pre, w_in, conv_w, conv_b, w_grp, pool_scale, w_a_out, w_b_out,
              w_o, g_post, w_ple, w_pgate):
    hp = x_prompt
    hs = x_sample
    conv_p, conv_s, pool_p, pool_s = [], [], [], []
    bp = x_prompt.shape[0]
    for i in range(DEPTH):
        lw = (g_pre[i], w_in[i], conv_w[i], conv_b[i], w_grp[i], pool_scale[i],
              w_a_out[i], w_b_out[i], w_o[i], g_post[i], w_ple[i], w_pgate[i])
        zc = jnp.zeros((bp, CONV_W - 1, D_CONV), hp.dtype)
        zp = jnp.zeros((bp, POOL_HIST, D_POOL), hp.dtype)
        hp, nc_p, np_p = _layer(hp, p_prompt[i], zc, zp, 0, *lw)
        hs, nc_s, np_s = _layer(hs, p_sample[i], cache_conv[i], state_pool[i], PAST_LEN, *lw)
        conv_p.append(nc_p); pool_p.append(np_p)
        conv_s.append(nc_s); pool_s.append(np_s)
    new_conv_prompt = jnp.stack(conv_p)
    new_conv_sample = jnp.stack(conv_s)
    new_pool_prompt = jnp.stack(pool_p)
    new_pool_sample = jnp.stack(pool_s)
    return (hp, hs, new_conv_prompt, new_conv_sample, new_pool_prompt, new_pool_sample)
```

```cpp
#include <hip/hip_runtime.h>
#include <cstdio>
#include <cstdint>


constexpr int DM = 1024, NB = 8, SEQ = 2048, DB = 32, DSEQ = 32, PLE = 256, NIN = 8192;
constexpr int MP = NB * SEQ;
constexpr int MS = DB * DSEQ;
constexpr int M = MP + MS;
constexpr float EPS = 1e-6f;
constexpr int NWAVES = 8;
constexpr int XPLD = DM + PLE;
constexpr int NCH = 16;

constexpr size_t MiB = 1u << 20;
constexpr size_t ACT = (size_t)M * DM * 2;
static_assert(ACT == 34 * MiB, "activation size");
constexpr size_t WS_CTL = 0, CTL_ZERO_BYTES = 1 * MiB;
constexpr size_t WS_BT1 = 1 * MiB;
constexpr size_t WS_WG = 17 * MiB;
constexpr size_t WS_WAB = 18 * MiB;
constexpr size_t WS_WO = 22 * MiB;
constexpr size_t WS_WPP = 24 * MiB;
constexpr size_t WS_SLOT = 26 * MiB + MiB / 2;
constexpr size_t WS_XP = 27 * MiB;
constexpr size_t WS_H = 70 * MiB;
constexpr size_t WS_XB = WS_H + ACT;
constexpr size_t WS_U = WS_XB + ACT;
constexpr size_t WS_R = WS_U + ACT;
constexpr size_t WS_SGB = WS_R + ACT;
constexpr size_t WS_HP = WS_SGB + ACT;
constexpr size_t WS_HC = WS_HP + (size_t)DB * 15 * DM * 2;
constexpr size_t WS_END = WS_HP + 2 * MiB;
constexpr size_t WS_ZR = 768 * 1024;
static_assert(WS_HC + (size_t)DB * 2 * DM * 2 <= WS_END && WS_ZR + 2048 <= CTL_ZERO_BYTES && WS_XP + (size_t)M * XPLD * 2 <= WS_H && WS_END <= 256 * MiB && WS_SLOT + (size_t)M * 16 <= WS_XP && WS_WPP + (size_t)DM * XPLD * 2 <= WS_SLOT, "d_ws map");
constexpr size_t OUT_Y = 0, OUT_NCP = (size_t)M * DM, OUT_NCS = OUT_NCP + 8 * 2 * DM, OUT_NPP = OUT_NCS + 32 * 2 * DM, OUT_NPS = OUT_NPP + 8 * 15 * DM, OUT_END = OUT_NPS + 32 * 15 * DM;
constexpr int CW_TMO = 0;
constexpr int CW_LBAR = 64;
constexpr int CW_BAR = 4096;
constexpr int CW_TMASK = 8192;
constexpr int CW_GMASK = 8448;
constexpr int CW_GRP = 32768;
constexpr int CW_TEAM = 24576;
constexpr int CW_SEAM = 16384;


namespace pg8 {
#define PG8_LAS __attribute__((address_space(3)))
typedef unsigned short bf16_t;
typedef short bf16x8 __attribute__((ext_vector_type(8)));
typedef float f32x4 __attribute__((ext_vector_type(4)));
typedef unsigned u32x4 __attribute__((ext_vector_type(4)));
typedef unsigned u32x2 __attribute__((ext_vector_type(2)));
constexpr int BM = 256, BK = 64, HALF = 128, HTB = HALF * BK * 2, STAGE_BYTES = 8 * HTB, NXCD = 8, WGM = 8;

__host__ __device__ __forceinline__ int lds_byte(int r, int c) { const int st = (r >> 4) * 2 + (c >> 5), rr = r & 15, cc = c & 31, ob = rr * 64 + cc * 2; return st * 1024 + (ob ^ (((ob >> 9) & 1) << 5)); }
__host__ __device__ __forceinline__ void stage_rc(int b, int& R, int& C) { const int st = b / 1024, sb = b % 1024, swz = sb ^ (((sb >> 9) & 1) << 5); R = (st >> 1) * 16 + swz / 64; C = (st & 1) * 32 + (swz % 64) / 2; }
__host__ __device__ __forceinline__ int perm32(int rho) { const int n = rho >> 4, i = rho & 15; return 8 * (i >> 2) + 4 * n + (i & 3); }

struct Unit { int pm, pn, seg; };
struct Gemm { const bf16_t* A; const bf16_t* Bt; int lda, ldb, acol, nt0, nt1, ao0, ao1, bo0, bo1; };

struct G1Order {
    int base, G, c, cnt;
    __device__ bool next(int i, Unit& u) const {
        if (i >= cnt) return false;
        const int L = base + i * G + c; if (L >= 2176) return false;
        if (L < 128) { const int x = L & 7, off = L >> 3; u.pm = 64 + (off & 3); u.pn = 4 * x + (off >> 2); }
        else { const int Lp = L - 128, x = Lp & 7, off = Lp >> 3; u.pm = 8 * x + (off & 7); u.pn = off >> 3; }
        u.seg = 0; return true;
    }
};
struct ListOrder {
    int first, stride, count, nseg;
    __device__ bool next(int i, Unit& u) const {
        const int j = (nseg == 2) ? (i >> 1) : i, sg = (nseg == 2) ? (i & 1) : 0;
        if (j >= count) return false;
        const int L = first + j * stride; u.pm = L >> 2; u.pn = L & 3; u.seg = sg; return true;
    }
};

__device__ __forceinline__ unsigned cvt_pk_bf16(float lo, float hi) { unsigned r; asm volatile("v_cvt_pk_bf16_f32 %0, %1, %2" : "=v"(r) : "v"(lo), "v"(hi)); return r; }
__device__ __forceinline__ float bf_lo(unsigned w) { return __uint_as_float(w << 16); }
__device__ __forceinline__ float bf_hi(unsigned w) { return __uint_as_float(w & 0xffff0000u); }
__device__ __forceinline__ u32x4 pack8(const f32x4 a, const f32x4 b) { u32x4 w; w.x = cvt_pk_bf16(a[0], a[1]); w.y = cvt_pk_bf16(a[2], a[3]); w.z = cvt_pk_bf16(b[0], b[1]); w.w = cvt_pk_bf16(b[2], b[3]); return w; }
__device__ __forceinline__ void unpack8(const u32x4 w, f32x4& a, f32x4& b) { a = (f32x4){bf_lo(w.x), bf_hi(w.x), bf_lo(w.y), bf_hi(w.y)}; b = (f32x4){bf_lo(w.z), bf_hi(w.z), bf_lo(w.w), bf_hi(w.w)}; }
__device__ __forceinline__ float expneg(float v) { return __builtin_amdgcn_exp2f(fminf(-1.44269504089f * v, 100.f)); }
__device__ __forceinline__ float sigm(float v) { return __builtin_amdgcn_rcpf(1.0f + expneg(v)); }
__device__ __forceinline__ f32x4 sigm4(const f32x4 v) { return (f32x4){sigm(v[0]), sigm(v[1]), sigm(v[2]), sigm(v[3])}; }
__device__ __forceinline__ f32x4 silu4(const f32x4 v) { return v * sigm4(v); }

struct EpiCtx { int wr, wc, fr, fq, wid, lane; PG8_LAS unsigned char* xl; PG8_LAS unsigned char* ring; };
#define PG8_GLDS16(ptr, slice, k) __builtin_amdgcn_global_load_lds((const unsigned*)(ptr), (PG8_LAS unsigned*)((slice) + (k) * 1024), 16, 0, 0)
#define PG8_LDSRD16(slice, k, lane) (*(const PG8_LAS u32x4*)((slice) + (k) * 1024 + (lane) * 16))
#define PG8_LDSRDF4(slice, k, lane) (*(const PG8_LAS f32x4*)((slice) + (k) * 1024 + (lane) * 16))

__device__ __forceinline__ int tail_idx(int r, int n_tail, bool& samp) {
    if (r < MP) { samp = false; const int t = r & (SEQ - 1), b = r >> 11; return t >= SEQ - n_tail ? b * n_tail + (t - (SEQ - n_tail)) : -1; }
    samp = true; const int rr = r - MP, t = rr & 31, s = rr >> 5; return t >= 32 - n_tail ? s * n_tail + (t - (32 - n_tail)) : -1;
}

struct EpiG1 {
    static constexpr bool SEG = false, STAGED = false;
    static constexpr size_t O_NCP = (size_t)M * DM, O_NCS = O_NCP + 8 * 2 * DM, O_NPP = O_NCS + 32 * 2 * DM, O_NPS = O_NPP + 8 * 15 * DM;
    unsigned char* ws; float* out;
    __device__ __forceinline__ void fin(f32x4 (&acc)[2][2][4][2], const Unit& u, const EpiCtx& c) const {
        const int pn = u.pn, rowb = u.pm * BM + c.wr * 64 + c.fr;
        bf16_t* const U = (bf16_t*)(ws + WS_U); bf16_t* const Q = (bf16_t*)out; bf16_t* const XB = (bf16_t*)(ws + WS_XB); bf16_t* const SB = (bf16_t*)out + DM; bf16_t* const R = (bf16_t*)(ws + WS_R); bf16_t* const SGB = (bf16_t*)(ws + WS_SGB);
        if (pn < 16 || pn >= 24) {
            const int ch = (pn & 7) * HALF + c.wc * 32 + 8 * c.fq;
#pragma unroll
            for (int ai = 0; ai < 2; ++ai)
#pragma unroll
                for (int m = 0; m < 4; ++m) { const int r = rowb + ai * HALF + m * 16; const size_t off = (size_t)r * DM + ch, off2 = (size_t)r * (2 * DM) + ch;
                    const f32x4 a0 = acc[ai][0][m][0], a1 = acc[ai][0][m][1], b0 = acc[ai][1][m][0], b1 = acc[ai][1][m][1];
                    if (pn < 8) { const f32x4 o0 = a0 * b0, o1 = a1 * b1; *(u32x4*)(U + off) = pack8(o0, o1);
                        bool samp; const int ti = tail_idx(r, 2, samp);
                        if (ti >= 0) { float* d = out + (samp ? O_NCS : O_NCP) + (size_t)ti * DM + ch; *(f32x4*)d = o0; *(f32x4*)(d + 4) = o1; } }
                    else if (pn < 16) { *(u32x4*)(Q + off2) = pack8(a0 * silu4(b0), a1 * silu4(b1)); }
                    else { f32x4 ea0, ea1, eb0, eb1;
#pragma unroll
                        for (int j = 0; j < 4; ++j) { ea0[j] = 1.f + expneg(a0[j]); ea1[j] = 1.f + expneg(a1[j]); eb0[j] = 1.f + expneg(b0[j]); eb1[j] = 1.f + expneg(b1[j]); }
                        f32x4 r0, r1, s0, s1;
#pragma unroll
                        for (int j = 0; j < 4; ++j) { r0[j] = eb0[j] * __builtin_amdgcn_rcpf(ea0[j]); r1[j] = eb1[j] * __builtin_amdgcn_rcpf(ea1[j]); s0[j] = __builtin_amdgcn_rcpf(eb0[j]); s1[j] = __builtin_amdgcn_rcpf(eb1[j]); }
                        *(u32x4*)(R + off) = pack8(r0, r1); *(u32x4*)(SGB + off) = pack8(s0, s1); } }
        } else {
            const int ch = (pn & 3) * BM + c.wc * 32 + 8 * c.fq;
#pragma unroll
            for (int ai = 0; ai < 2; ++ai)
#pragma unroll
                for (int m = 0; m < 4; ++m) { const int r = rowb + ai * HALF + m * 16; const size_t off = (size_t)r * DM + ch, off2 = (size_t)r * (2 * DM) + ch;
                    if (pn < 20) { bool samp; const int ti = tail_idx(r, 15, samp);
#pragma unroll
                        for (int bj = 0; bj < 2; ++bj) { *(u32x4*)(XB + off + bj * HALF) = pack8(acc[ai][bj][m][0], acc[ai][bj][m][1]);
                            if (ti >= 0) { float* d = out + (samp ? O_NPS : O_NPP) + (size_t)ti * DM + ch + bj * HALF; *(f32x4*)d = acc[ai][bj][m][0]; *(f32x4*)(d + 4) = acc[ai][bj][m][1]; } } }
                    else {
#pragma unroll
                        for (int bj = 0; bj < 2; ++bj) *(u32x4*)(SB + off2 + bj * HALF) = pack8(silu4(acc[ai][bj][m][0]), silu4(acc[ai][bj][m][1])); } }
        }
    }
};

struct EpiG2 {
    static constexpr bool SEG = false, STAGED = true;
    bf16_t* SB; const float* ps;
    __device__ __forceinline__ void fin(f32x4 (&acc)[2][2][4][2], const Unit& u, const EpiCtx& c) const {
        const int row0 = u.pm * BM + c.wr * 64 + c.fr, col0 = u.pn * BM + c.wc * 32 + 8 * c.fq;
        f32x4 pv[2][2];
#pragma unroll
        for (int bj = 0; bj < 2; ++bj)
#pragma unroll
            for (int n = 0; n < 2; ++n) pv[bj][n] = *(const f32x4*)(ps + col0 + bj * HALF + 4 * n);
#pragma unroll
        for (int ai = 0; ai < 2; ++ai)
#pragma unroll
            for (int m = 0; m < 4; ++m) { const size_t off = (size_t)(row0 + ai * HALF + m * 16) * (2 * DM) + col0;
#pragma unroll
                for (int bj = 0; bj < 2; ++bj) { f32x4 s0, s1; unpack8(*(const u32x4*)(SB + off + bj * HALF), s0, s1);
                    *(u32x4*)(SB + off + bj * HALF) = pack8(acc[ai][bj][m][0] * pv[bj][0] * s0, acc[ai][bj][m][1] * pv[bj][1] * s1); } }
    }
    __device__ __forceinline__ void fin_staged(f32x4 (&acc)[2][2][4][2], const Unit& u, const EpiCtx& c) const {
        const int row0 = u.pm * BM + c.wr * 64 + c.fr, col0 = u.pn * BM + c.wc * 32 + 8 * c.fq;
        PG8_LAS unsigned char* slice = c.ring + c.wid * 16384;
#pragma unroll
        for (int ai = 0; ai < 2; ++ai)
#pragma unroll
            for (int m = 0; m < 4; ++m)
#pragma unroll
                for (int bj = 0; bj < 2; ++bj) PG8_GLDS16(SB + (size_t)(row0 + ai * HALF + m * 16) * (2 * DM) + col0 + bj * HALF, slice, ai * 8 + m * 2 + bj);
        f32x4 pv[2][2];
#pragma unroll
        for (int bj = 0; bj < 2; ++bj)
#pragma unroll
            for (int n = 0; n < 2; ++n) pv[bj][n] = *(const f32x4*)(ps + col0 + bj * HALF + 4 * n);
        asm volatile("s_waitcnt vmcnt(0)" ::: "memory");
#pragma unroll
        for (int ai = 0; ai < 2; ++ai)
#pragma unroll
            for (int m = 0; m < 4; ++m) { const size_t off = (size_t)(row0 + ai * HALF + m * 16) * (2 * DM) + col0;
#pragma unroll
                for (int bj = 0; bj < 2; ++bj) { f32x4 s0, s1; unpack8(PG8_LDSRD16(slice, ai * 8 + m * 2 + bj, c.lane), s0, s1);
                    *(u32x4*)(SB + off + bj * HALF) = pack8(acc[ai][bj][m][0] * pv[bj][0] * s0, acc[ai][bj][m][1] * pv[bj][1] * s1); } }
    }
};

struct EpiG34 {
    static constexpr bool SEG = true, STAGED = false;
    const bf16_t *R, *SGB; bf16_t* Mm;
    static constexpr bool ZERO_AFTER_MID = false;
    __device__ __forceinline__ void mid(f32x4 (&acc)[2][2][4][2], const Unit& u, const EpiCtx& c) const {
        const int row0 = u.pm * BM + c.wr * 64 + c.fr, col0 = u.pn * BM + c.wc * 32 + 8 * c.fq;
#pragma unroll
        for (int ai = 0; ai < 2; ++ai)
#pragma unroll
            for (int m = 0; m < 4; ++m) { const size_t off = (size_t)(row0 + ai * HALF + m * 16) * DM + col0;
#pragma unroll
                for (int bj = 0; bj < 2; ++bj) { f32x4 s0, s1; unpack8(*(const u32x4*)(R + off + bj * HALF), s0, s1); acc[ai][bj][m][0] *= s0; acc[ai][bj][m][1] *= s1; } }
    }
    __device__ __forceinline__ void fin(f32x4 (&acc)[2][2][4][2], const Unit& u, const EpiCtx& c) const {
        const int row0 = u.pm * BM + c.wr * 64 + c.fr, col0 = u.pn * BM + c.wc * 32 + 8 * c.fq;
#pragma unroll
        for (int ai = 0; ai < 2; ++ai)
#pragma unroll
            for (int m = 0; m < 4; ++m) { const size_t off = (size_t)(row0 + ai * HALF + m * 16) * DM + col0;
#pragma unroll
                for (int bj = 0; bj < 2; ++bj) { f32x4 s0, s1; unpack8(*(const u32x4*)(SGB + off + bj * HALF), s0, s1);
                    *(u32x4*)(Mm + off + bj * HALF) = pack8(acc[ai][bj][m][0] * s0, acc[ai][bj][m][1] * s1); } }
    }
    __device__ __forceinline__ void fin_staged(f32x4 (&acc)[2][2][4][2], const Unit& u, const EpiCtx& c) const {
        const int row0 = u.pm * BM + c.wr * 64 + c.fr, col0 = u.pn * BM + c.wc * 32 + 8 * c.fq;
        PG8_LAS unsigned char* slice = c.ring + c.wid * 16384;
#pragma unroll
        for (int ai = 0; ai < 2; ++ai)
#pragma unroll
            for (int m = 0; m < 4; ++m)
#pragma unroll
                for (int bj = 0; bj < 2; ++bj) PG8_GLDS16(SGB + (size_t)(row0 + ai * HALF + m * 16) * DM + col0 + bj * HALF, slice, ai * 8 + m * 2 + bj);
        asm volatile("s_waitcnt vmcnt(0)" ::: "memory");
#pragma unroll
        for (int ai = 0; ai < 2; ++ai)
#pragma unroll
            for (int m = 0; m < 4; ++m) { const size_t off = (size_t)(row0 + ai * HALF + m * 16) * DM + col0;
#pragma unroll
                for (int bj = 0; bj < 2; ++bj) { f32x4 s0, s1; unpack8(PG8_LDSRD16(slice, ai * 8 + m * 2 + bj, c.lane), s0, s1);
                    *(u32x4*)(Mm + off + bj * HALF) = pack8(acc[ai][bj][m][0] * s0, acc[ai][bj][m][1] * s1); } }
    }
};

struct EpiG5 {
    static constexpr bool SEG = false, STAGED = true;
    const float *xp, *xs, *gpost; float* Y; bf16_t* X1b; float* slots; unsigned* cnt; unsigned* tmo;
    __device__ __forceinline__ void exchange(f32x4 (&acc)[2][2][4][2], const Unit& u, const EpiCtx& c) const {
        PG8_LAS float* P = (PG8_LAS float*)c.xl;
        PG8_LAS float* S = (PG8_LAS float*)(c.xl + 4096);
        PG8_LAS unsigned* flag = (PG8_LAS unsigned*)(c.xl + 4096 + 1024);
#pragma unroll
        for (int ai = 0; ai < 2; ++ai)
#pragma unroll
            for (int m = 0; m < 4; ++m) { float s = 0.f;
#pragma unroll
                for (int bj = 0; bj < 2; ++bj)
#pragma unroll
                    for (int n = 0; n < 2; ++n) { const f32x4 x = acc[ai][bj][m][n]; s += (x[0] * x[0] + x[1] * x[1]) + (x[2] * x[2] + x[3] * x[3]); }
                { const auto r16 = __builtin_amdgcn_permlane16_swap(__float_as_uint(s), __float_as_uint(s), false, false); s = __uint_as_float(r16[0]) + __uint_as_float(r16[1]); }
                { const auto r32 = __builtin_amdgcn_permlane32_swap(__float_as_uint(s), __float_as_uint(s), false, false); s = __uint_as_float(r32[0]) + __uint_as_float(r32[1]); }
                if (c.fq == 0) P[(ai * HALF + c.wr * 64 + m * 16 + c.fr) * 4 + c.wc] = s; }
        asm volatile("s_waitcnt lgkmcnt(0)" ::: "memory"); __builtin_amdgcn_s_barrier(); asm volatile("" ::: "memory");
        const int row = c.wid * 32 + (c.lane & 31);
        if (c.lane < 32) { const float tot = (P[row * 4 + 0] + P[row * 4 + 1]) + (P[row * 4 + 2] + P[row * 4 + 3]);
            __hip_atomic_store((unsigned*)slots + ((size_t)(u.pm * BM + row) * 4 + u.pn), __float_as_uint(tot), __ATOMIC_RELAXED, __HIP_MEMORY_SCOPE_AGENT); }
        asm volatile("s_waitcnt vmcnt(0)" ::: "memory");
        if (c.lane == 0) __hip_atomic_fetch_add(cnt + 64 * u.pm, 1u, __ATOMIC_RELAXED, __HIP_MEMORY_SCOPE_AGENT);
        if (c.wid == 0) { bool dead = false; unsigned spins = 0;
            for (;;) {
                if ((unsigned)__builtin_amdgcn_readfirstlane(__hip_atomic_load(cnt + 64 * u.pm, __ATOMIC_RELAXED, __HIP_MEMORY_SCOPE_AGENT)) >= 32u) break;
                if (++spins > (1u << 18)) { if (c.lane == 0) __hip_atomic_store(tmo, 1u, __ATOMIC_RELAXED, __HIP_MEMORY_SCOPE_AGENT); dead = true; break; }
                __builtin_amdgcn_s_sleep(2); }
            __builtin_amdgcn_fence(__ATOMIC_ACQUIRE, "agent");
            if (c.lane == 0) flag[0] = dead ? 1u : 0u; }
        asm volatile("s_waitcnt vmcnt(0) lgkmcnt(0)" ::: "memory"); __builtin_amdgcn_s_barrier(); asm volatile("" ::: "memory");
        if (c.lane < 32) { const unsigned* sl = (const unsigned*)slots + (size_t)(u.pm * BM + row) * 4; float q = 0.f;
#pragma unroll
            for (int t = 0; t < 4; ++t) q += __uint_as_float(__hip_atomic_load(sl + t, __ATOMIC_RELAXED, __HIP_MEMORY_SCOPE_AGENT));
            S[row] = 1.0f / sqrtf(q * (1.0f / DM) + EPS); }
        asm volatile("s_waitcnt lgkmcnt(0)" ::: "memory"); __builtin_amdgcn_s_barrier(); asm volatile("" ::: "memory");
    }
    __device__ __forceinline__ void fin(f32x4 (&acc)[2][2][4][2], const Unit& u, const EpiCtx& c) const {
        exchange(acc, u, c);
        const PG8_LAS float* S = (const PG8_LAS float*)(c.xl + 4096);
        const int row0 = u.pm * BM + c.wr * 64 + c.fr, col0 = u.pn * BM + c.wc * 32 + 8 * c.fq;
        const float* xb = (u.pm * BM < MP) ? xp : xs - (size_t)MP * DM;
        f32x4 gv[2][2];
#pragma unroll
        for (int bj = 0; bj < 2; ++bj)
#pragma unroll
            for (int n = 0; n < 2; ++n) gv[bj][n] = *(const f32x4*)(gpost + col0 + bj * HALF + 4 * n);
#pragma unroll
        for (int ai = 0; ai < 2; ++ai)
#pragma unroll
            for (int m = 0; m < 4; ++m) { const int rl = ai * HALF + c.wr * 64 + m * 16 + c.fr; const float rs = S[rl]; const size_t off = (size_t)(row0 + ai * HALF + m * 16) * DM + col0;
#pragma unroll
                for (int bj = 0; bj < 2; ++bj) { const f32x4 x0 = *(const f32x4*)(xb + off + bj * HALF), x1 = *(const f32x4*)(xb + off + bj * HALF + 4);
                    const f32x4 o0 = x0 + acc[ai][bj][m][0] * rs * gv[bj][0], o1 = x1 + acc[ai][bj][m][1] * rs * gv[bj][1];
                    *(u32x4*)(X1b + (size_t)(row0 + ai * HALF + m * 16) * XPLD + col0 + bj * HALF) = pack8(o0, o1); }
                if (m & 1) asm volatile("" ::: "memory"); }
    }
    __device__ __forceinline__ void fin_staged(f32x4 (&acc)[2][2][4][2], const Unit& u, const EpiCtx& c) const {
        const int row0 = u.pm * BM + c.wr * 64 + c.fr, col0 = u.pn * BM + c.wc * 32 + 8 * c.fq;
        const float* xb = (u.pm * BM < MP) ? xp : xs - (size_t)MP * DM;
        PG8_LAS unsigned char* slice = c.ring + c.wid * 16384;
#pragma unroll
        for (int m = 0; m < 4; ++m)
#pragma unroll
            for (int bj = 0; bj < 2; ++bj)
#pragma unroll
                for (int q = 0; q < 2; ++q) PG8_GLDS16(xb + (size_t)(row0 + m * 16) * DM + col0 + bj * HALF + 4 * q, slice, m * 4 + bj * 2 + q);
        exchange(acc, u, c);
        const PG8_LAS float* S = (const PG8_LAS float*)(c.xl + 4096);
        f32x4 gv[2][2];
#pragma unroll
        for (int bj = 0; bj < 2; ++bj)
#pragma unroll
            for (int n = 0; n < 2; ++n) gv[bj][n] = *(const f32x4*)(gpost + col0 + bj * HALF + 4 * n);
#pragma unroll
        for (int ai = 0; ai < 2; ++ai) {
            asm volatile("s_waitcnt vmcnt(0)" ::: "memory");
            f32x4 xr[4][2][2];
#pragma unroll
            for (int m = 0; m < 4; ++m)
#pragma unroll
                for (int bj = 0; bj < 2; ++bj)
#pragma unroll
                    for (int q = 0; q < 2; ++q) xr[m][bj][q] = PG8_LDSRDF4(slice, m * 4 + bj * 2 + q, c.lane);
            if (ai == 0) { asm volatile("s_waitcnt lgkmcnt(0)" ::: "memory");
#pragma unroll
                for (int m = 0; m < 4; ++m)
#pragma unroll
                    for (int bj = 0; bj < 2; ++bj)
#pragma unroll
                        for (int q = 0; q < 2; ++q) PG8_GLDS16(xb + (size_t)(row0 + HALF + m * 16) * DM + col0 + bj * HALF + 4 * q, slice, m * 4 + bj * 2 + q); }
#pragma unroll
            for (int m = 0; m < 4; ++m) { const float rs = S[ai * HALF + c.wr * 64 + m * 16 + c.fr];
#pragma unroll
                for (int bj = 0; bj < 2; ++bj) { const f32x4 o0 = xr[m][bj][0] + acc[ai][bj][m][0] * rs * gv[bj][0], o1 = xr[m][bj][1] + acc[ai][bj][m][1] * rs * gv[bj][1];
                    *(u32x4*)(X1b + (size_t)(row0 + ai * HALF + m * 16) * XPLD + col0 + bj * HALF) = pack8(o0, o1); } }
        }
    }
};

struct EpiG6 {
    static constexpr bool SEG = true, ZERO_AFTER_MID = true, STAGED = true;
    float* Y; bf16_t* E; const bf16_t* X1b;
    __device__ __forceinline__ void mid(f32x4 (&acc)[2][2][4][2], const Unit& u, const EpiCtx& c) const {
        const int row0 = u.pm * BM + c.wr * 64 + c.fr, col0 = u.pn * BM + c.wc * 32 + 8 * c.fq;
#pragma unroll
        for (int ai = 0; ai < 2; ++ai)
#pragma unroll
            for (int m = 0; m < 4; ++m) { bf16_t* rowp = E + (size_t)(row0 + ai * HALF + m * 16) * DM + col0;
#pragma unroll
                for (int bj = 0; bj < 2; ++bj) *(u32x4*)(rowp + bj * HALF) = pack8(acc[ai][bj][m][0], acc[ai][bj][m][1]); }
    }
    __device__ __forceinline__ void fin(f32x4 (&acc)[2][2][4][2], const Unit& u, const EpiCtx& c) const {
        const int row0 = u.pm * BM + c.wr * 64 + c.fr, col0 = u.pn * BM + c.wc * 32 + 8 * c.fq;
#pragma unroll
        for (int ai = 0; ai < 2; ++ai)
#pragma unroll
            for (int m = 0; m < 4; ++m) { const size_t off = (size_t)(row0 + ai * HALF + m * 16) * DM + col0;
#pragma unroll
                for (int bj = 0; bj < 2; ++bj) { f32x4 x0, x1; unpack8(*(const u32x4*)(X1b + (size_t)(row0 + ai * HALF + m * 16) * XPLD + col0 + bj * HALF), x0, x1);
                    f32x4 e0, e1; unpack8(*(const u32x4*)(E + off + bj * HALF), e0, e1);
                    *(f32x4*)(Y + off + bj * HALF) = x0 + e0 * sigm4(acc[ai][bj][m][0]); *(f32x4*)(Y + off + bj * HALF + 4) = x1 + e1 * sigm4(acc[ai][bj][m][1]); }
                if (m & 1) asm volatile("" ::: "memory"); }
    }
    __device__ __forceinline__ void fin_staged(f32x4 (&acc)[2][2][4][2], const Unit& u, const EpiCtx& c) const {
        const int row0 = u.pm * BM + c.wr * 64 + c.fr, col0 = u.pn * BM + c.wc * 32 + 8 * c.fq;
        PG8_LAS unsigned char* slice = c.ring + c.wid * 16384;
#pragma unroll
        for (int ai = 0; ai < 2; ++ai) {
            if (ai == 0) {
#pragma unroll
                for (int m = 0; m < 4; ++m)
#pragma unroll
                    for (int bj = 0; bj < 2; ++bj) { const int r = row0 + m * 16;
                        PG8_GLDS16(X1b + (size_t)r * XPLD + col0 + bj * HALF, slice, m * 4 + bj * 2); PG8_GLDS16(E + (size_t)r * DM + col0 + bj * HALF, slice, m * 4 + bj * 2 + 1); } }
            asm volatile("s_waitcnt vmcnt(0)" ::: "memory");
            u32x4 xr[4][2], er[4][2];
#pragma unroll
            for (int m = 0; m < 4; ++m)
#pragma unroll
                for (int bj = 0; bj < 2; ++bj) { xr[m][bj] = PG8_LDSRD16(slice, m * 4 + bj * 2, c.lane); er[m][bj] = PG8_LDSRD16(slice, m * 4 + bj * 2 + 1, c.lane); }
            if (ai == 0) { asm volatile("s_waitcnt lgkmcnt(0)" ::: "memory");
#pragma unroll
                for (int m = 0; m < 4; ++m)
#pragma unroll
                    for (int bj = 0; bj < 2; ++bj) { const int r = row0 + HALF + m * 16;
                        PG8_GLDS16(X1b + (size_t)r * XPLD + col0 + bj * HALF, slice, m * 4 + bj * 2); PG8_GLDS16(E + (size_t)r * DM + col0 + bj * HALF, slice, m * 4 + bj * 2 + 1); } }
#pragma unroll
            for (int m = 0; m < 4; ++m) { const size_t off = (size_t)(row0 + ai * HALF + m * 16) * DM + col0;
#pragma unroll
                for (int bj = 0; bj < 2; ++bj) { f32x4 x0, x1, e0, e1; unpack8(xr[m][bj], x0, x1); unpack8(er[m][bj], e0, e1);
                    *(f32x4*)(Y + off + bj * HALF) = x0 + e0 * sigm4(acc[ai][bj][m][0]); *(f32x4*)(Y + off + bj * HALF + 4) = x1 + e1 * sigm4(acc[ai][bj][m][1]); } }
        }
    }
};

template <class Epi, class Sched>
__device__ __forceinline__ void gemm_phase(PG8_LAS unsigned char* lds, PG8_LAS unsigned char* xl, const int wid_in, const Gemm g, const Sched& S, const Epi& E) {
    int wid_ = wid_in; asm volatile("" : "+s"(wid_)); const int wid = wid_;
    int lane_ = (int)__builtin_amdgcn_mbcnt_hi(~0u, __builtin_amdgcn_mbcnt_lo(~0u, 0u)); asm volatile("" : "+v"(lane_));
    const int lane = lane_, tid = wid * 64 + lane, wr = wid >> 2, wc = wid & 3, fr = lane & 15, fq = lane >> 4;
    unsigned voffA, voffB;
    { int R, C; stage_rc(tid * 16, R, C); const int Rb = (R & ~31) + perm32(R & 31); voffA = (unsigned)(R * g.lda + C) * 2u; voffB = (unsigned)(Rb * g.ldb + C) * 2u; }
    const size_t p2A = (size_t)64 * g.lda * 2, p2B = (size_t)64 * g.ldb * 2;
    const size_t kstep = (size_t)(BK * 2);
    const size_t hstepA = (size_t)HALF * g.lda * 2, hstepB = (size_t)HALF * g.ldb * 2;
    const unsigned ldsw = (unsigned)wid * 1024u;
    const int aoff = lds_byte(wr * 64 + fr, fq * 8), boff = lds_byte(wc * 32 + fr, fq * 8);
    EpiCtx ctx; ctx.wr = wr; ctx.wc = wc; ctx.fr = fr; ctx.fq = fq; ctx.wid = wid; ctx.lane = lane; ctx.xl = xl; ctx.ring = lds;
#define PG8_UA(u) ((const char*)g.A + ((long)(u).pm * BM * g.lda + (long)(u).pn * g.acol + (long)((u).seg ? g.ao1 : g.ao0)) * 2)
#define PG8_UB(u) ((const char*)g.Bt + ((long)(u).pn * BM * g.ldb + (long)((u).seg ? g.bo1 : g.bo0)) * 2)
#define PG8_SA(b, h) (((b) * 2 + (h)) * HTB)
#define PG8_SB(b, h) ((4 + (b) * 2 + (h)) * HTB)
#define PG8_STAGE(bufoff, gbase, voff) do { \
        __builtin_amdgcn_global_load_lds((const unsigned*)((const char*)(gbase) + (voff)), (PG8_LAS unsigned*)(lds + (bufoff) + ldsw), 16, 0, 0); \
        __builtin_amdgcn_global_load_lds((const unsigned*)((const char*)(gbase) + (&(voff) == &voffA ? p2A : p2B) + (voff)), (PG8_LAS unsigned*)(lds + (bufoff) + ldsw + 8192), 16, 0, 0); } while (0)
#define PG8_LDA(dst, b, h) do { _Pragma("unroll") for (int m = 0; m < 4; ++m) _Pragma("unroll") for (int k = 0; k < 2; ++k) dst[m][k] = *(const PG8_LAS bf16x8*)(lds + PG8_SA(b, h) + aoff + m * 2048 + k * 1024); } while (0)
#define PG8_LDB(dst, b, h) do { _Pragma("unroll") for (int n = 0; n < 2; ++n) _Pragma("unroll") for (int k = 0; k < 2; ++k) dst[n][k] = *(const PG8_LAS bf16x8*)(lds + PG8_SB(b, h) + boff + n * 2048 + k * 1024); } while (0)
#define PG8_MMA(ai, bj, At, Bt) do { __builtin_amdgcn_s_setprio(1); _Pragma("unroll") for (int m = 0; m < 4; ++m) _Pragma("unroll") for (int n = 0; n < 2; ++n) _Pragma("unroll") for (int k = 0; k < 2; ++k) \
        acc[ai][bj][m][n] = __builtin_amdgcn_mfma_f32_16x16x32_bf16(Bt[n][k], At[m][k], acc[ai][bj][m][n], 0, 0, 0); __builtin_amdgcn_s_setprio(0); } while (0)
#define PG8_WAIT_V(n) asm volatile("s_waitcnt vmcnt(" #n ")" ::: "memory")
#define PG8_WAIT_L(n) asm volatile("s_waitcnt lgkmcnt(" #n ")" ::: "memory")
#define PG8_BAR __builtin_amdgcn_s_barrier()
#define PG8_SCHED __builtin_amdgcn_sched_barrier(0)
    Unit cur, nxt; int ui = 0;
    if (!S.next(0, cur)) return;
    f32x4 acc[2][2][4][2];
#pragma unroll
    for (int a = 0; a < 2; ++a)
#pragma unroll
        for (int b = 0; b < 2; ++b)
#pragma unroll
            for (int m = 0; m < 4; ++m)
#pragma unroll
                for (int n = 0; n < 2; ++n) acc[a][b][m][n] = (f32x4){0.f, 0.f, 0.f, 0.f};
    bf16x8 At[4][2], B0[2][2], B1[2][2];
    const char* cA = PG8_UA(cur); const char* cB = PG8_UB(cur);
    PG8_STAGE(PG8_SB(0, 0), cB, voffB); PG8_STAGE(PG8_SB(0, 1), cB + hstepB, voffB); PG8_STAGE(PG8_SA(0, 0), cA, voffA); PG8_STAGE(PG8_SA(0, 1), cA + hstepA, voffA);
    if (wr == 1) PG8_BAR;
    PG8_WAIT_V(2); PG8_BAR;
    PG8_STAGE(PG8_SB(1, 0), cB + kstep, voffB); PG8_STAGE(PG8_SA(1, 0), cA + kstep, voffA); PG8_STAGE(PG8_SB(1, 1), cB + hstepB + kstep, voffB);
    PG8_WAIT_V(6); PG8_BAR;
    for (;;) {
        const bool has_next = S.next(ui + 1, nxt);
        const char* nA = has_next ? PG8_UA(nxt) : cA; const char* nB = has_next ? PG8_UB(nxt) : cB;
        const int nt = cur.seg ? g.nt1 : g.nt0;
        for (int t = 0; t < nt; t += 2) {
            const bool last = (t == nt - 2);
            const char* a1 = cA + (size_t)(t + 1) * kstep;
            const char* a2 = last ? nA : cA + (size_t)(t + 2) * kstep; const char* b2 = last ? nB : cB + (size_t)(t + 2) * kstep;
            const char* a3 = a2 + kstep; const char* b3 = b2 + kstep;
            PG8_LDB(B0, 0, 0); PG8_LDB(B1, 0, 1); PG8_SCHED; PG8_LDA(At, 0, 0); PG8_STAGE(PG8_SA(1, 1), a1 + hstepA, voffA);
            PG8_WAIT_V(8); PG8_WAIT_L(0); PG8_BAR; PG8_MMA(0, 0, At, B0); PG8_MMA(0, 1, At, B1); PG8_BAR; PG8_SCHED;
            PG8_LDA(At, 0, 1); PG8_STAGE(PG8_SB(0, 0), b2, voffB); PG8_STAGE(PG8_SB(0, 1), b2 + hstepB, voffB); PG8_STAGE(PG8_SA(0, 0), a2, voffA);
            PG8_WAIT_V(8); PG8_WAIT_L(0); PG8_BAR; PG8_MMA(1, 0, At, B0); PG8_MMA(1, 1, At, B1); PG8_BAR; PG8_SCHED;
            PG8_LDB(B0, 1, 0); PG8_LDB(B1, 1, 1); PG8_SCHED; PG8_LDA(At, 1, 0); PG8_STAGE(PG8_SA(0, 1), a2 + hstepA, voffA);
            PG8_WAIT_V(8); PG8_WAIT_L(0); PG8_BAR; PG8_MMA(0, 0, At, B0); PG8_MMA(0, 1, At, B1); PG8_BAR; PG8_SCHED;
            PG8_LDA(At, 1, 1); PG8_STAGE(PG8_SB(1, 0), b3, voffB); PG8_STAGE(PG8_SB(1, 1), b3 + hstepB, voffB); PG8_STAGE(PG8_SA(1, 0), a3, voffA);
            PG8_WAIT_V(8); PG8_WAIT_L(0); PG8_BAR; PG8_MMA(1, 0, At, B0); PG8_MMA(1, 1, At, B1); PG8_BAR; PG8_SCHED;
        }
        if (wr == 0) PG8_BAR;
        bool zero = true;
        { int le = (int)__builtin_amdgcn_mbcnt_hi(~0u, __builtin_amdgcn_mbcnt_lo(~0u, 0u)); asm volatile("" : "+v"(le)); ctx.lane = le; ctx.fr = le & 15; ctx.fq = le >> 4; }
        const bool defer = Epi::STAGED && !has_next;
        if constexpr (Epi::SEG) { if (cur.seg == 0) { E.mid(acc, cur, ctx); zero = Epi::ZERO_AFTER_MID; } else if (!defer) E.fin(acc, cur, ctx); }
        else { if (!defer) E.fin(acc, cur, ctx); }
        if (!has_next) break;
        if (zero) {
#pragma unroll
            for (int a = 0; a < 2; ++a)
#pragma unroll
                for (int b = 0; b < 2; ++b)
#pragma unroll
                    for (int m = 0; m < 4; ++m)
#pragma unroll
                        for (int n = 0; n < 2; ++n) acc[a][b][m][n] = (f32x4){0.f, 0.f, 0.f, 0.f};
        }
        cur = nxt; cA = nA; cB = nB; ++ui;
        if (wr == 1) PG8_BAR;
    }
    PG8_WAIT_V(0);
    PG8_BAR;
    if constexpr (Epi::STAGED) {
        { int le = (int)__builtin_amdgcn_mbcnt_hi(~0u, __builtin_amdgcn_mbcnt_lo(~0u, 0u)); asm volatile("" : "+v"(le)); ctx.lane = le; ctx.fr = le & 15; ctx.fq = le >> 4; }
        E.fin_staged(acc, cur, ctx);
    }
#undef PG8_UA
#undef PG8_UB
#undef PG8_SA
#undef PG8_SB
#undef PG8_STAGE
#undef PG8_LDA
#undef PG8_LDB
#undef PG8_MMA
#undef PG8_WAIT_V
#undef PG8_WAIT_L
#undef PG8_BAR
#undef PG8_SCHED
}
}

constexpr int RING_BYTES = 131072;
constexpr int XL_OFF = RING_BYTES;
constexpr int MISC_OFF = XL_OFF + 8192;
constexpr int LDS_BYTES = 147456;
static_assert(MISC_OFF + 128 <= LDS_BYTES, "LDS map");

#define GAS __attribute__((address_space(1)))
#define LAS __attribute__((address_space(3)))
typedef unsigned short bf16;
typedef unsigned v4u __attribute__((ext_vector_type(4)));
typedef float f32x4 __attribute__((ext_vector_type(4)));
typedef GAS unsigned gu32;
#define RLX_AGENT __ATOMIC_RELAXED, __HIP_MEMORY_SCOPE_AGENT
#define LDS_WAIT() asm volatile("s_waitcnt lgkmcnt(0)" ::: "memory")
#define VM_WAIT() asm volatile("s_waitcnt vmcnt(0)" ::: "memory")
__device__ __forceinline__ unsigned f2bf(float f) { unsigned u = __builtin_bit_cast(unsigned, f); return (u + 0x7fffu + ((u >> 16) & 1u)) >> 16; }
__device__ __forceinline__ unsigned pk2(float lo, float hi) { return f2bf(lo) | (f2bf(hi) << 16); }

#define XB_TMO      128
#define XB_XCNT(j)  (256  + 64 * (j))
#define XB_XSUB(j)  (1280 + 64 * (j))
#define XB_XGEN(j)  (2304 + 64 * (j))
#define XB_TOP      3328
#define XB_TOPGEN   3392
#define XCD_BAR_WORDS 3456
#define XB_SPIN_CAP (1u << 18)
__device__ __forceinline__ unsigned xb_ld(unsigned* p)              { return __hip_atomic_load(p, __ATOMIC_RELAXED, __HIP_MEMORY_SCOPE_AGENT); }
__device__ __forceinline__ unsigned xb_add(unsigned* p, unsigned v) { return __hip_atomic_fetch_add(p, v, __ATOMIC_RELAXED, __HIP_MEMORY_SCOPE_AGENT); }
__device__ __forceinline__ unsigned xb_xcc_id() { return (unsigned)__builtin_amdgcn_s_getreg((3 << 11) | 20) & 0xFu; }
#define XB_SPIN(cond, bar) do { unsigned _sp = 0; while (cond) { __builtin_amdgcn_s_sleep(1); \
    if ((++_sp & 255u) == 0u) { if (xb_ld(&(bar)[XB_TMO])) break; if (_sp > XB_SPIN_CAP) { atomicAdd(&(bar)[XB_TMO], 1u); break; } } } } while (0)
struct XcdBarrier { unsigned* bar; unsigned x; volatile LAS unsigned* st; };
__device__ __forceinline__ int lane_id_opaque() { int l = (int)__builtin_amdgcn_mbcnt_hi(~0u, __builtin_amdgcn_mbcnt_lo(~0u, 0u)); asm volatile("" : "+v"(l)); return l; }
#define XB_LEADER(wave) ((wave) == 0 && lane_id_opaque() == 0)
__device__ __forceinline__ XcdBarrier xcd_barrier_post(unsigned* bar, volatile LAS unsigned* st, int wave) {
    XcdBarrier b; b.bar = bar; b.x = xb_xcc_id(); b.st = st;
    if (XB_LEADER(wave)) (void)xb_add(&bar[XB_XCNT(b.x)], 1u);
    return b;
}
__device__ __forceinline__ void xcd_barrier_complete(unsigned* bar, unsigned x, unsigned& nloc, unsigned& nx) {
    const unsigned G = gridDim.x * gridDim.y * gridDim.z;
    unsigned sum, cnt, mine, sp = 0u;
    for (;;) {
        sum = 0u; cnt = 0u; mine = 0u;
#pragma unroll
        for (unsigned j = 0; j < 16; ++j) { const unsigned c = xb_ld(&bar[XB_XCNT(j)]); sum += c; cnt += (c > 0u) ? 1u : 0u; mine = (j == x) ? c : mine; }
        if (sum == G) break;
        __builtin_amdgcn_s_sleep(1);
        if ((++sp & 255u) == 0u) { if (xb_ld(&bar[XB_TMO])) break; if (sp > XB_SPIN_CAP) { atomicAdd(&bar[XB_TMO], 1u); break; } }
    }
    nloc = mine > 0u ? mine : 1u; nx = cnt > 0u ? cnt : 1u;
}
__device__ __forceinline__ void xcd_barrier(const XcdBarrier& b, int wave) {
    asm volatile("s_waitcnt vmcnt(0)" ::: "memory");
    __syncthreads();
    if (XB_LEADER(wave)) {
        unsigned* bar = b.bar;
        __builtin_amdgcn_s_waitcnt(0);
        unsigned nloc = b.st[0], nx = b.st[1];
        if (nloc == 0u) { xcd_barrier_complete(bar, b.x, nloc, nx); b.st[0] = nloc; b.st[1] = nx; }
        const unsigned old = xb_add(&bar[XB_XSUB(b.x)], 1u);
        const unsigned gen = old / nloc;
        if (old + 1u == (gen + 1u) * nloc) {
            __builtin_amdgcn_fence(__ATOMIC_RELEASE, "agent");
            asm volatile("s_waitcnt vmcnt(0)" ::: "memory");
            const unsigned og = xb_add(&bar[XB_TOP], 1u);
            const unsigned tg = og / nx;
            if (og + 1u == (tg + 1u) * nx) xb_add(&bar[XB_TOPGEN], 1u);
            else XB_SPIN(xb_ld(&bar[XB_TOPGEN]) == tg, bar);
            __builtin_amdgcn_fence(__ATOMIC_ACQUIRE, "agent");
            xb_add(&bar[XB_XGEN(b.x)], 1u);
            asm volatile("s_waitcnt vmcnt(0)" ::: "memory");
        } else {
            XB_SPIN(xb_ld(&bar[XB_XGEN(b.x)]) == gen, bar);
            __builtin_amdgcn_fence(__ATOMIC_ACQUIRE, "agent");
            asm volatile("s_waitcnt vmcnt(0)" ::: "memory");
        }
    }
    __syncthreads();
}
__device__ __forceinline__ void chain_barrier(unsigned* cnt, unsigned target, unsigned* tmo, int wave) {
    asm volatile("s_waitcnt vmcnt(0)" ::: "memory");
    __syncthreads();
    if (XB_LEADER(wave)) {
        __builtin_amdgcn_fence(__ATOMIC_RELEASE, "agent");
        asm volatile("s_waitcnt vmcnt(0)" ::: "memory");
        xb_add(cnt, 1u);
        unsigned sp = 0u;
        while (xb_ld(cnt) < target) { __builtin_amdgcn_s_sleep(1); if ((++sp & 255u) == 0u) { if (xb_ld(tmo)) break; if (sp > XB_SPIN_CAP) { atomicAdd(tmo, 1u); break; } } }
        __builtin_amdgcn_fence(__ATOMIC_ACQUIRE, "agent");
        asm volatile("s_waitcnt vmcnt(0)" ::: "memory");
    }
    __syncthreads();
}

__device__ __forceinline__ void team_barrier(unsigned* cnt, unsigned target, bool same_xcd, unsigned* tmo, int wave) {
    asm volatile("s_waitcnt vmcnt(0)" ::: "memory");
    __syncthreads();
    if (XB_LEADER(wave)) {
        if (!same_xcd) { __builtin_amdgcn_fence(__ATOMIC_RELEASE, "agent"); asm volatile("s_waitcnt vmcnt(0)" ::: "memory"); }
        xb_add(cnt, 1u);
        unsigned sp = 0u;
        while (xb_ld(cnt) < target) { __builtin_amdgcn_s_sleep(1); if ((++sp & 255u) == 0u) { if (xb_ld(tmo)) break; if (sp > XB_SPIN_CAP) { atomicAdd(tmo, 1u); break; } } }
        __builtin_amdgcn_fence(__ATOMIC_ACQUIRE, "agent");
        asm volatile("s_waitcnt vmcnt(0)" ::: "memory");
    }
    __syncthreads();
}

struct Args { const float* in[18]; float* out; unsigned char* ws; };

__device__ __forceinline__ float wave_sum(float v) {
#pragma unroll
    for (int o = 1; o < 64; o <<= 1) v += __shfl_xor(v, o);
    return v;
}
__device__ __forceinline__ void p0_transpose_item(const float* W, int N, bf16* WT, int ldt, int koff, int row_off, LAS float* scr, int kb, int nb, int lane) {
    const int k0 = 64 * kb, n0 = 32 * nb;
    float tv[32];
#pragma unroll
    for (int i = 0; i < 32; ++i) tv[i] = __builtin_nontemporal_load(W + (size_t)(k0 + 2 * i + (lane >> 5)) * N + n0 + (lane & 31));
#pragma unroll
    for (int i = 0; i < 32; ++i) scr[(2 * i + (lane >> 5)) * 33 + (lane & 31)] = tv[i];
    LDS_WAIT(); asm volatile("" ::: "memory");
    const int c = lane & 7;
#pragma unroll
    for (int j = 0; j < 4; ++j) { const int n = (lane >> 3) + 8 * j; const LAS float* s = scr + (8 * c) * 33 + n;
        v4u o; o.x = pk2(s[0 * 33], s[1 * 33]); o.y = pk2(s[2 * 33], s[3 * 33]); o.z = pk2(s[4 * 33], s[5 * 33]); o.w = pk2(s[6 * 33], s[7 * 33]);
        *(GAS v4u*)(WT + (size_t)(row_off + n0 + n) * ldt + koff + k0 + 8 * c) = o; }
    LDS_WAIT(); asm volatile("" ::: "memory");
}
__device__ __forceinline__ int win_dest_row(int n) {
    const int seg = n >> 10, c = n & 1023, t = c >> 7, i = c & 127;
    switch (seg) {
        case 0: return 256 * t + i;
        case 2: return 256 * t + 128 + i;
        case 1: return 256 * (8 + t) + i;
        case 3: return 256 * (8 + t) + 128 + i;
        case 4: return 4096 + c;
        case 5: return 5120 + c;
        case 6: return 256 * (24 + t) + i;
        default: return 256 * (24 + t) + 128 + i;
    }
}

#define EW_LD16(base, boff) (*(const pg8::u32x4*)((const char*)(base) + (unsigned)(boff)))
#define EW_LDF4(base, boff) (*(const f32x4*)((const char*)(base) + (unsigned)(boff)))
#define EW_ST16(base, boff, v) (*(pg8::u32x4*)((char*)(base) + (unsigned)(boff)) = (v))
template <int W>
__device__ __forceinline__ void ew_strip(int m0, int ch, const unsigned char* ws, bf16* AB, const float* conv_w, const float* conv_b) {
    const bool samp = m0 >= MP; const int t0 = samp ? ((m0 - MP) & 31) : (m0 & (SEQ - 1)); const int sidx = samp ? (m0 - MP) >> 5 : 0;
    const int mbase = m0 - t0;
    const unsigned zoff = (unsigned)WS_ZR + (unsigned)ch * 2u;
    {
        pg8::u32x4 xr[W - 1 + 8];
#pragma unroll
        for (int i = 0; i < W - 1 + 8; ++i) { const int t = t0 - (W - 1) + i;
            const unsigned o = t >= 0 ? (unsigned)WS_XB + (unsigned)((mbase + t) * DM + ch) * 2u : (samp ? (unsigned)WS_HP + (unsigned)((sidx * 15 + 15 + t) * DM + ch) * 2u : zoff);
            xr[i] = EW_LD16(ws, o); }
        f32x4 s0 = (f32x4){0.f, 0.f, 0.f, 0.f}, s1 = s0;
#pragma unroll
        for (int i = 0; i < W - 1; ++i) { f32x4 a, b; pg8::unpack8(xr[i], a, b); s0 += a; s1 += b; }
        const unsigned dofs = (unsigned)WS_H + (unsigned)(m0 * DM + ch) * 2u;
#pragma unroll
        for (int i = 0; i < 8; ++i) { f32x4 a, b; pg8::unpack8(xr[W - 1 + i], a, b); s0 += a; s1 += b;
            const int t = t0 + i; const float inv = 1.0f / (float)(samp ? W : (t + 1 < W ? t + 1 : W));
            EW_ST16(ws, dofs + (unsigned)i * (DM * 2), pg8::pack8(s0 * inv - a, s1 * inv - b));
            f32x4 oa, ob; pg8::unpack8(xr[i], oa, ob); s0 -= oa; s1 -= ob; }
    }
    asm volatile("" ::: "memory");
    {
        const unsigned qo = (unsigned)(m0 * (2 * DM) + ch) * 2u;
        pg8::u32x4 ur[10], qr[8];
#pragma unroll
        for (int i = 0; i < 10; ++i) { const int t = t0 - 2 + i;
            const unsigned o = t >= 0 ? (unsigned)WS_U + (unsigned)((mbase + t) * DM + ch) * 2u : (samp ? (unsigned)WS_HC + (unsigned)((sidx * 2 + 2 + t) * DM + ch) * 2u : zoff);
            ur[i] = EW_LD16(ws, o); }
#pragma unroll
        for (int i = 0; i < 8; ++i) qr[i] = EW_LD16(AB, qo + (unsigned)i * (DM * 4));
        const f32x4 w00 = EW_LDF4(conv_w, ch * 4), w01 = EW_LDF4(conv_w, ch * 4 + 16), w10 = EW_LDF4(conv_w, (DM + ch) * 4), w11 = EW_LDF4(conv_w, (DM + ch) * 4 + 16),
                    w20 = EW_LDF4(conv_w, (2 * DM + ch) * 4), w21 = EW_LDF4(conv_w, (2 * DM + ch) * 4 + 16), b0 = EW_LDF4(conv_b, ch * 4), b1 = EW_LDF4(conv_b, ch * 4 + 16);
        f32x4 p0, p1, c0, c1; pg8::unpack8(ur[0], p0, p1); pg8::unpack8(ur[1], c0, c1);
#pragma unroll
        for (int i = 0; i < 8; ++i) { f32x4 n0, n1, q0, q1; pg8::unpack8(ur[2 + i], n0, n1); pg8::unpack8(qr[i], q0, q1);
            EW_ST16(AB, qo + (unsigned)i * (DM * 4), pg8::pack8(q0 * (b0 + w00 * p0 + w10 * c0 + w20 * n0), q1 * (b1 + w01 * p1 + w11 * c1 + w21 * n1)));
            p0 = c0; p1 = c1; c0 = n0; c1 = n1; }
    }
    asm volatile("" ::: "memory");
}
template <int W>
__device__ __forceinline__ void ew_quarter_t(int pm, int g, int tid, const unsigned char* ws, bf16* AB, const float* conv_w, const float* conv_b) {
    const int cvq = tid & 31, sA = tid >> 5, ch = 256 * g + 8 * cvq;
    for (int h = 0; h < 2; ++h) ew_strip<W>(pm * 256 + 8 * (sA + 16 * h), ch, ws, AB, conv_w, conv_b);
}
__device__ __forceinline__ void ew_quarter(int pm, int g, int tid, const unsigned char* ws, bf16* AB, const float* conv_w, const float* conv_b) {
    switch (g) {
        case 0: ew_quarter_t<2>(pm, g, tid, ws, AB, conv_w, conv_b); break;
        case 1: ew_quarter_t<4>(pm, g, tid, ws, AB, conv_w, conv_b); break;
        case 2: ew_quarter_t<8>(pm, g, tid, ws, AB, conv_w, conv_b); break;
        default: ew_quarter_t<16>(pm, g, tid, ws, AB, conv_w, conv_b); break;
    }
}

typedef const __attribute__((address_space(4))) unsigned long long* kargp_t;
__device__ __forceinline__ unsigned long long karg64(int idx) { kargp_t kp = (kargp_t)__builtin_amdgcn_kernarg_segment_ptr(); asm volatile("" : "+s"(kp)); return kp[idx]; }
#define KIN(k) ((const float*)karg64(k))
#define KOUT() ((float*)karg64(18))
#define KWS() ((unsigned char*)karg64(19))

__global__ void __launch_bounds__(NWAVES * 64, 2) fwd_mega(Args args) {
    extern __shared__ __attribute__((aligned(16))) unsigned char lds_raw[];
    LAS unsigned char* lds = (LAS unsigned char*)lds_raw;
    volatile LAS unsigned* MISC = (volatile LAS unsigned*)(lds + MISC_OFF);
    const int wave = __builtin_amdgcn_readfirstlane((int)threadIdx.x >> 6);
#define LANE_ID() lane_id_opaque()
#define TID() (wave * 64 + LANE_ID())
    const int G = gridDim.x; const int bx = blockIdx.x; const int vcu = (G % 8 == 0) ? (bx % 8) * (G / 8) + bx / 8 : bx;
    (void)args;

    for (int u = TID(); u < (LDS_BYTES - XL_OFF) / 4; u += NWAVES * 64) ((LAS unsigned*)(lds + XL_OFF))[u] = 0u;
    __syncthreads();
    { const XcdBarrier b0 = xcd_barrier_post((unsigned*)(KWS() + WS_CTL) + CW_BAR, MISC + 8, wave); if (TID() == 0) { MISC[10] = b0.x; __hip_atomic_fetch_or((unsigned*)(KWS() + WS_CTL) + CW_TMASK + (vcu >> 2), 1u << b0.x, __ATOMIC_RELAXED, __HIP_MEMORY_SCOPE_AGENT);
        __hip_atomic_fetch_or((unsigned*)(KWS() + WS_CTL) + CW_GMASK + (bx & 7), 1u << b0.x, __ATOMIC_RELAXED, __HIP_MEMORY_SCOPE_AGENT); } }
    __syncthreads();
#define GRID_BAR() do { XcdBarrier b_; b_.bar = (unsigned*)(KWS() + WS_CTL) + CW_BAR; b_.st = MISC + 8; b_.x = (unsigned)__builtin_amdgcn_readfirstlane((int)MISC[10]); xcd_barrier(b_, wave); } while (0)
    LAS unsigned char* xl = lds + XL_OFF;
    const int NG1 = G - NCH;
    const bool chain = bx >= NG1; const int ci = bx - NG1;

    {
        unsigned char* ws = KWS();
        const float *x_p = KIN(0), *x_s = KIN(1), *p_p = KIN(2), *p_s = KIN(3), *g_pre = KIN(6), *w_in = KIN(7), *w_grp = KIN(10), *w_a = KIN(12), *w_b = KIN(13), *w_o = KIN(14), *w_ple = KIN(16), *w_pg = KIN(17);
        bf16 *BT1 = (bf16*)(ws + WS_BT1), *WG = (bf16*)(ws + WS_WG), *WAB = (bf16*)(ws + WS_WAB), *WO = (bf16*)(ws + WS_WO), *WPP = (bf16*)(ws + WS_WPP), *XP = (bf16*)(ws + WS_XP), *H = (bf16*)(ws + WS_H);
        const int lane = LANE_ID();
        LAS float* scr = (LAS float*)(lds + wave * 16384);
        const int gw = vcu * NWAVES + wave, NGW = G * NWAVES;
        constexpr int I_IN = 16 * 256, I_SQ = 16 * 32, I_PLE = 4 * 32, I_G = 4 * 4 * 8, NITEMS = I_IN + 4 * I_SQ + I_PLE + I_G;
        for (int it = gw; it < NITEMS; it += NGW) {
            int r = it;
            if (r < I_IN) { const int kb = r / 256, nb = r % 256; p0_transpose_item(w_in, NIN, BT1, DM, 0, win_dest_row(32 * nb) - 32 * nb, scr, kb, nb, lane); continue; } r -= I_IN;
            if (r < I_SQ) { p0_transpose_item(w_a, DM, WAB, 2 * DM, 0, 0, scr, r / 32, r % 32, lane); continue; } r -= I_SQ;
            if (r < I_SQ) { p0_transpose_item(w_b, DM, WAB, 2 * DM, DM, 0, scr, r / 32, r % 32, lane); continue; } r -= I_SQ;
            if (r < I_SQ) { p0_transpose_item(w_o, DM, WO, DM, 0, 0, scr, r / 32, r % 32, lane); continue; } r -= I_SQ;
            if (r < I_SQ) { p0_transpose_item(w_pg, DM, WPP, XPLD, 0, 0, scr, r / 32, r % 32, lane); continue; } r -= I_SQ;
            if (r < I_PLE) { p0_transpose_item(w_ple, DM, WPP, XPLD, DM, 0, scr, r / 32, r % 32, lane); continue; } r -= I_PLE;
            { const int g = r / 32, q = r % 32; p0_transpose_item(w_grp + (size_t)g * 256 * 256, 256, WG + (size_t)g * 256 * 256, 256, 0, 0, scr, q / 8, q % 8, lane); }
        }
        f32x4 gv[2][2];
#pragma unroll
        for (int j = 0; j < 2; ++j) { gv[j][0] = ((const GAS f32x4*)(g_pre + 512 * j))[2 * lane]; gv[j][1] = ((const GAS f32x4*)(g_pre + 512 * j))[2 * lane + 1]; }
        for (int m4 = gw; m4 < M / 4; m4 += NGW) {
            const int m = 4 * m4;
            const float* xrow = m < MP ? x_p + (size_t)m * DM : x_s + (size_t)(m - MP) * DM;
            const float* prow = m < MP ? p_p + (size_t)m * PLE : p_s + (size_t)(m - MP) * PLE;
            f32x4 v[4][2][2], pv[4];
#pragma unroll
            for (int r = 0; r < 4; ++r) {
#pragma unroll
                for (int j = 0; j < 2; ++j) { v[r][j][0] = __builtin_nontemporal_load((const GAS f32x4*)(xrow + (size_t)r * DM + 512 * j) + 2 * lane); v[r][j][1] = __builtin_nontemporal_load((const GAS f32x4*)(xrow + (size_t)r * DM + 512 * j) + 2 * lane + 1); }
                pv[r] = __builtin_nontemporal_load((const GAS f32x4*)(prow + (size_t)r * PLE) + lane); }
            __builtin_amdgcn_sched_barrier(0);
#pragma unroll
            for (int r = 0; r < 4; ++r) { float s = 0.f;
#pragma unroll
                for (int j = 0; j < 2; ++j)
#pragma unroll
                    for (int q = 0; q < 2; ++q) { const f32x4 t = v[r][j][q]; s += (t.x * t.x + t.y * t.y) + (t.z * t.z + t.w * t.w); }
                const float rstd = 1.f / sqrtf(wave_sum(s) * (1.f / DM) + EPS);
#pragma unroll
                for (int j = 0; j < 2; ++j) { const f32x4 y0 = v[r][j][0] * rstd * gv[j][0], y1 = v[r][j][1] * rstd * gv[j][1];
                    v4u o; o.x = pk2(y0.x, y0.y); o.y = pk2(y0.z, y0.w); o.z = pk2(y1.x, y1.y); o.w = pk2(y1.z, y1.w);
                    ((GAS v4u*)(H + (size_t)(m + r) * DM + 512 * j))[lane] = o; }
                ((GAS unsigned long long*)(XP + (size_t)(m + r) * XPLD + DM))[lane] = (unsigned long long)pk2(pv[r].x, pv[r].y) | ((unsigned long long)pk2(pv[r].z, pv[r].w) << 32); }
        }
        { const float *state_pool = KIN(5), *cache_conv = KIN(4); bf16 *HP = (bf16*)(ws + WS_HP), *HC = (bf16*)(ws + WS_HC);
          const int gt = gw * 64 + lane, NT = NGW * 64; constexpr int NP8 = DB * 15 * DM / 8, NC8 = DB * 2 * DM / 8;
          for (int i = gt; i < NP8 + NC8; i += NT) { const bool isp = i < NP8; const int k = isp ? i : i - NP8; const float* src = (isp ? state_pool : cache_conv) + (size_t)k * 8;
              const f32x4 a = *(const GAS f32x4*)src, b = *(const GAS f32x4*)(src + 4); v4u o; o.x = pk2(a.x, a.y); o.y = pk2(a.z, a.w); o.z = pk2(b.x, b.y); o.w = pk2(b.z, b.w);
              *(GAS v4u*)((isp ? HP : HC) + (size_t)k * 8) = o; } }
        VM_WAIT(); __syncthreads();
        GRID_BAR();
    }

    for (int part = 0; part < 2; ++part) {
        if (part == 0 || !chain) {
            unsigned char* ws = KWS(); float* out = KOUT();
            pg8::EpiG1 E1{ws, out};
            const pg8::Gemm g1{(bf16*)(ws + WS_H), (bf16*)(ws + WS_BT1), DM, DM, 0, 16, 16, 0, 0, 0, 0};
            pg8::G1Order S{part == 0 ? 0 : G, part == 0 ? G : NG1, bx, part == 0 ? 1 : (1 << 20)};
            pg8::gemm_phase<pg8::EpiG1, pg8::G1Order>(lds, xl, wave, g1, S, E1);
        }
        if (part == 0) GRID_BAR();
    }

    unsigned lb_epoch = 0, tb_epoch = 0;
    for (int rnd = 0; rnd < 2; ++rnd) {
        const bool act = (rnd == 1) || chain;
        const int first = rnd == 0 ? 256 + ci : vcu, stride = rnd == 0 ? 1 : G, count = rnd == 0 ? 1 : (256 - vcu + G - 1) / G;
#define STAGE_BAR() do { if (rnd == 1) { if (G == 256) { ++tb_epoch; unsigned* ctl_ = (unsigned*)(KWS() + WS_CTL); const unsigned tm_ = xb_ld(ctl_ + CW_TMASK + (vcu >> 2)); team_barrier(ctl_ + CW_TEAM + 64 * (vcu >> 2), 4u * tb_epoch, (tm_ & (tm_ - 1u)) == 0u, ctl_ + CW_TMO, wave); } else GRID_BAR(); } else if (chain) { ++lb_epoch; unsigned* ctl_ = (unsigned*)(KWS() + WS_CTL); team_barrier(ctl_ + CW_TEAM + 64 * (64 + (ci >> 2)), 4u * lb_epoch, false, ctl_ + CW_TMO, wave); } } while (0)
        if (act) {
            unsigned char* ws = KWS(); bf16* AB = (bf16*)KOUT();
            { const float *conv_w = KIN(8), *conv_b = KIN(9);
              int tid_e = TID(); asm volatile("" : "+v"(tid_e));
              for (int j = 0; j < count; ++j) { const int L = first + j * stride; ew_quarter(L >> 2, L & 3, tid_e, ws, AB, conv_w, conv_b); } }
            VM_WAIT(); __syncthreads();
            if (TID() == 0) { __builtin_amdgcn_fence(__ATOMIC_ACQUIRE, "agent"); VM_WAIT(); }
            __syncthreads();
            const pg8::Gemm g{(bf16*)(ws + WS_H), (bf16*)(ws + WS_WG), DM, 256, 256, 4, 4, 0, 0, 0, 0}; pg8::ListOrder S{first, stride, count, 1};
            pg8::EpiG2 E{AB + DM, KIN(11)};
            pg8::gemm_phase<pg8::EpiG2, pg8::ListOrder>(lds, xl, wave, g, S, E);
        } STAGE_BAR();
        if (act) {
            unsigned char* ws = KWS(); bf16* AB = (bf16*)KOUT();
            const pg8::Gemm g{AB, (bf16*)(ws + WS_WAB), 2 * DM, 2 * DM, 0, 16, 16, 0, DM, 0, DM}; pg8::ListOrder S{first, stride, count, 2};
            pg8::EpiG34 E{(bf16*)(ws + WS_R), (bf16*)(ws + WS_SGB), (bf16*)(ws + WS_H)};
            pg8::gemm_phase<pg8::EpiG34, pg8::ListOrder>(lds, xl, wave, g, S, E);
        } STAGE_BAR();
        if (act) {
            unsigned char* ws = KWS(); unsigned* ctl_ = (unsigned*)(ws + WS_CTL);
            const pg8::Gemm g{(bf16*)(ws + WS_H), (bf16*)(ws + WS_WO), DM, DM, 0, 16, 16, 0, 0, 0, 0}; pg8::ListOrder S{first, stride, count, 1};
            pg8::EpiG5 E{KIN(0), KIN(1), KIN(15), KOUT() + OUT_Y, (bf16*)(ws + WS_XP), (float*)(ws + WS_SLOT), ctl_ + CW_SEAM, ctl_ + CW_TMO};
            pg8::gemm_phase<pg8::EpiG5, pg8::ListOrder>(lds, xl, wave, g, S, E);
        } STAGE_BAR();
        if (act) {
            unsigned char* ws = KWS();
            const pg8::Gemm g{(bf16*)(ws + WS_XP), (bf16*)(ws + WS_WPP), XPLD, XPLD, 0, 4, 16, DM, 0, DM, 0}; pg8::ListOrder S{first, stride, count, 2};
            pg8::EpiG6 E{KOUT() + OUT_Y, (bf16*)(ws + WS_H), (const bf16*)(ws + WS_XP)};
            pg8::gemm_phase<pg8::EpiG6, pg8::ListOrder>(lds, xl, wave, g, S, E);
        }
        if (rnd == 0) {
            if (G == 256) { unsigned* ctl_ = (unsigned*)(KWS() + WS_CTL); const unsigned gm_ = xb_ld(ctl_ + CW_GMASK + (bx & 7)); team_barrier(ctl_ + CW_GRP + 64 * (bx & 7), 32u, (gm_ & (gm_ - 1u)) == 0u, ctl_ + CW_TMO, wave); }
            else GRID_BAR(); }
#undef STAGE_BAR
    }
}

extern "C" void kernel_launch(void* const* d_in, const int* in_sizes, int n_in, void* d_out, int out_size, void* d_ws, size_t ws_size, hipStream_t stream) {
    static int grid = 0;
    if (grid == 0) {
        if (n_in != 18 || in_sizes[0] != MP * DM || (size_t)out_size != OUT_END || ws_size < WS_END) {
            fprintf(stderr, "kernel_launch: unexpected shapes: n_in %d in0 %d out %d ws %zu (need >= %zu)\n", n_in, n_in > 0 ? in_sizes[0] : -1, out_size, ws_size, (size_t)WS_END); grid = -1; return; }
        int dev = 0, cus = 0, per_cu = 0;
        if (hipGetDevice(&dev) != hipSuccess || hipDeviceGetAttribute(&cus, hipDeviceAttributeMultiprocessorCount, dev) != hipSuccess) { grid = -1; return; }
        if (hipFuncSetAttribute((const void*)fwd_mega, hipFuncAttributeMaxDynamicSharedMemorySize, LDS_BYTES) != hipSuccess) { fprintf(stderr, "kernel_launch: hipFuncSetAttribute failed\n"); grid = -1; return; }
        if (hipOccupancyMaxActiveBlocksPerMultiprocessor(&per_cu, (const void*)fwd_mega, NWAVES * 64, LDS_BYTES) != hipSuccess || per_cu < 1)
            fprintf(stderr, "kernel_launch: note: occupancy query reports %d workgroups per CU\n", per_cu);
        (void)hipGetLastError();
        grid = cus;
        if (grid % 8 != 0) grid -= grid % 8;
        if (grid < 64) { fprintf(stderr, "kernel_launch: only %d CUs\n", cus); grid = -1; return; }
    }
    if (grid < 0) return;
    if (hipMemsetAsync((char*)d_ws + WS_CTL, 0, CTL_ZERO_BYTES, stream) != hipSuccess) { fprintf(stderr, "kernel_launch: memset failed\n"); return; }
    Args a{};
    for (int i = 0; i < 18; ++i) a.in[i] = (const float*)d_in[i];
    a.out = (float*)d_out; a.ws = (unsigned char*)d_ws;
    hipLaunchKernelGGL(fwd_mega, dim3(grid), dim3(NWAVES * 64), LDS_BYTES, stream, a);
}
```

```cpp
#include <hip/hip_runtime.h>
#include <cstdio>
#include <cstdint>


constexpr int DM = 1024, NB = 8, SEQ = 2048, DB = 32, DSEQ = 32, PLE = 256, NIN = 8192;
constexpr int MP = NB * SEQ;
constexpr int MS = DB * DSEQ;
constexpr int M = MP + MS;
constexpr float EPS = 1e-6f;
constexpr int NWAVES = 8;
constexpr int XPLD = DM + PLE;
constexpr int NCH = 16;

constexpr size_t MiB = 1u << 20;
constexpr size_t ACT = (size_t)M * DM * 2;
static_assert(ACT == 34 * MiB, "activation size");
constexpr size_t WS_CTL = 0, CTL_ZERO_BYTES = 1 * MiB;
constexpr size_t WS_BT1 = 1 * MiB;
constexpr size_t WS_WG = 17 * MiB;
constexpr size_t WS_WAB = 18 * MiB;
constexpr size_t WS_WO = 22 * MiB;
constexpr size_t WS_WPP = 24 * MiB;
constexpr size_t WS_SLOT = 26 * MiB + MiB / 2;
constexpr size_t WS_XP = 27 * MiB;
constexpr size_t WS_H = 70 * MiB;
constexpr size_t WS_XB = WS_H + ACT;
constexpr size_t WS_U = WS_XB + ACT;
constexpr size_t WS_R = WS_U + ACT;
constexpr size_t WS_SGB = WS_R + ACT;
constexpr size_t WS_HP = WS_SGB + ACT;
constexpr size_t WS_HC = WS_HP + (size_t)DB * 15 * DM * 2;
constexpr size_t WS_SIDE = WS_HP + 2 * MiB;
constexpr size_t WS_CW = WS_SIDE + (size_t)68 * 6 * DM * 4;
constexpr size_t WS_END = 244 * MiB;
constexpr size_t WS_ZR = 768 * 1024;
static_assert(WS_CW + 4 * DM * 4 <= WS_END && WS_HC + (size_t)DB * 2 * DM * 2 <= WS_SIDE && WS_ZR + 2048 <= CTL_ZERO_BYTES && WS_XP + (size_t)M * XPLD * 2 <= WS_H && WS_END <= 256 * MiB && WS_SLOT + (size_t)M * 16 <= WS_XP && WS_WPP + (size_t)DM * XPLD * 2 <= WS_SLOT, "d_ws map");
constexpr size_t OUT_Y = 0, OUT_NCP = (size_t)M * DM, OUT_NCS = OUT_NCP + 8 * 2 * DM, OUT_NPP = OUT_NCS + 32 * 2 * DM, OUT_NPS = OUT_NPP + 8 * 15 * DM, OUT_END = OUT_NPS + 32 * 15 * DM;
constexpr int CW_TMO = 0;
constexpr int CW_LBAR = 64;
constexpr int CW_BAR = 4096;
constexpr int CW_TMASK = 8192;
constexpr int CW_GMASK = 8448;
constexpr int CW_GRP = 32768;
constexpr int CW_TEAM = 24576;
constexpr int CW_SEAM = 16384;


namespace pg8 {
#define PG8_LAS __attribute__((address_space(3)))
typedef unsigned short bf16_t;
typedef short bf16x8 __attribute__((ext_vector_type(8)));
typedef float f32x4 __attribute__((ext_vector_type(4)));
typedef unsigned u32x4 __attribute__((ext_vector_type(4)));
typedef unsigned u32x2 __attribute__((ext_vector_type(2)));
constexpr int BM = 256, BK = 64, HALF = 128, HTB = HALF * BK * 2, STAGE_BYTES = 8 * HTB, NXCD = 8, WGM = 8;

__host__ __device__ __forceinline__ int lds_byte(int r, int c) { const int st = (r >> 4) * 2 + (c >> 5), rr = r & 15, cc = c & 31, ob = rr * 64 + cc * 2; return st * 1024 + (ob ^ (((ob >> 9) & 1) << 5)); }
__host__ __device__ __forceinline__ void stage_rc(int b, int& R, int& C) { const int st = b / 1024, sb = b % 1024, swz = sb ^ (((sb >> 9) & 1) << 5); R = (st >> 1) * 16 + swz / 64; C = (st & 1) * 32 + (swz % 64) / 2; }
__host__ __device__ __forceinline__ int perm32(int rho) { const int n = rho >> 4, i = rho & 15; return 8 * (i >> 2) + 4 * n + (i & 3); }

struct Unit { int pm, pn, seg; };
struct Gemm { const bf16_t* A; const bf16_t* Bt; int lda, ldb, acol, nt0, nt1, ao0, ao1, bo0, bo1; };

struct G1Order {
    int base, G, c, cnt;
    __device__ bool next(int i, Unit& u) const {
        if (i >= cnt) return false;
        const int L = base + i * G + c; if (L >= 2176) return false;
        if (L < 128) { const int x = L & 7, off = L >> 3; u.pm = 64 + (off & 3); u.pn = 4 * x + (off >> 2); }
        else { const int Lp = L - 128, x = Lp & 7, off = Lp >> 3; u.pm = 8 * x + (off & 7); u.pn = off >> 3; }
        u.seg = 0; return true;
    }
};
struct ListOrder {
    int first, stride, count, nseg;
    __device__ bool next(int i, Unit& u) const {
        const int j = (nseg == 2) ? (i >> 1) : i, sg = (nseg == 2) ? (i & 1) : 0;
        if (j >= count) return false;
        const int L = first + j * stride; u.pm = L >> 2; u.pn = L & 3; u.seg = sg; return true;
    }
};

__device__ __forceinline__ unsigned cvt_pk_bf16(float lo, float hi) { unsigned r; asm volatile("v_cvt_pk_bf16_f32 %0, %1, %2" : "=v"(r) : "v"(lo), "v"(hi)); return r; }
__device__ __forceinline__ float bf_lo(unsigned w) { return __uint_as_float(w << 16); }
__device__ __forceinline__ float bf_hi(unsigned w) { return __uint_as_float(w & 0xffff0000u); }
__device__ __forceinline__ u32x4 pack8(const f32x4 a, const f32x4 b) { u32x4 w; w.x = cvt_pk_bf16(a[0], a[1]); w.y = cvt_pk_bf16(a[2], a[3]); w.z = cvt_pk_bf16(b[0], b[1]); w.w = cvt_pk_bf16(b[2], b[3]); return w; }
__device__ __forceinline__ void unpack8(const u32x4 w, f32x4& a, f32x4& b) { a = (f32x4){bf_lo(w.x), bf_hi(w.x), bf_lo(w.y), bf_hi(w.y)}; b = (f32x4){bf_lo(w.z), bf_hi(w.z), bf_lo(w.w), bf_hi(w.w)}; }
__device__ __forceinline__ float expneg(float v) { return __builtin_amdgcn_exp2f(fminf(-1.44269504089f * v, 100.f)); }
__device__ __forceinline__ float sigm(float v) { return __builtin_amdgcn_rcpf(1.0f + expneg(v)); }
__device__ __forceinline__ f32x4 sigm4(const f32x4 v) { return (f32x4){sigm(v[0]), sigm(v[1]), sigm(v[2]), sigm(v[3])}; }
__device__ __forceinline__ f32x4 silu4(const f32x4 v) { return v * sigm4(v); }

struct EpiCtx { int wr, wc, fr, fq, wid, lane; PG8_LAS unsigned char* xl; PG8_LAS unsigned char* ring; };
#define PG8_GLDS16(ptr, slice, k) __builtin_amdgcn_global_load_lds((const unsigned*)(ptr), (PG8_LAS unsigned*)((slice) + (k) * 1024), 16, 0, 0)
#define PG8_LDSRD16(slice, k, lane) (*(const PG8_LAS u32x4*)((slice) + (k) * 1024 + (lane) * 16))
#define PG8_LDSRDF4(slice, k, lane) (*(const PG8_LAS f32x4*)((slice) + (k) * 1024 + (lane) * 16))

__device__ __forceinline__ int tail_idx(int r, int n_tail, bool& samp) {
    if (r < MP) { samp = false; const int t = r & (SEQ - 1), b = r >> 11; return t >= SEQ - n_tail ? b * n_tail + (t - (SEQ - n_tail)) : -1; }
    samp = true; const int rr = r - MP, t = rr & 31, s = rr >> 5; return t >= 32 - n_tail ? s * n_tail + (t - (32 - n_tail)) : -1;
}

__device__ __forceinline__ float dpp_shr(float old, float v, int n) { return n == 1 ? __builtin_bit_cast(float, __builtin_amdgcn_update_dpp(__builtin_bit_cast(int, old), __builtin_bit_cast(int, v), 0x111, 0xf, 0xf, false))
                                                                                       : __builtin_bit_cast(float, __builtin_amdgcn_update_dpp(__builtin_bit_cast(int, old), __builtin_bit_cast(int, v), 0x112, 0xf, 0xf, false)); }
__device__ __forceinline__ float dpp_ror(float v, int n) { return n == 1 ? __builtin_bit_cast(float, __builtin_amdgcn_update_dpp(0, __builtin_bit_cast(int, v), 0x121, 0xf, 0xf, false))
                                                                           : __builtin_bit_cast(float, __builtin_amdgcn_update_dpp(0, __builtin_bit_cast(int, v), 0x122, 0xf, 0xf, false)); }
__device__ __forceinline__ f32x4 dpp_shr4(const f32x4 old, const f32x4 v, int n) { return (f32x4){dpp_shr(old[0], v[0], n), dpp_shr(old[1], v[1], n), dpp_shr(old[2], v[2], n), dpp_shr(old[3], v[3], n)}; }
__device__ __forceinline__ f32x4 dpp_ror4(const f32x4 v, int n) { return (f32x4){dpp_ror(v[0], n), dpp_ror(v[1], n), dpp_ror(v[2], n), dpp_ror(v[3], n)}; }
__device__ __forceinline__ u32x2 pack4(const f32x4 a) { u32x2 w; w.x = cvt_pk_bf16(a[0], a[1]); w.y = cvt_pk_bf16(a[2], a[3]); return w; }

struct EpiG1 {
    static constexpr bool SEG = false, STAGED = false;
    static constexpr size_t O_NCP = (size_t)M * DM, O_NCS = O_NCP + 8 * 2 * DM, O_NPP = O_NCS + 32 * 2 * DM, O_NPS = O_NPP + 8 * 15 * DM;
    unsigned char* ws; float* out;
    __device__ __forceinline__ void fin(f32x4 (&acc)[2][2][4][2], const Unit& u, const EpiCtx& c) const {
        const int pn = u.pn, rowb = u.pm * BM + c.wr * 64 + c.fr;
        bf16_t* const AB = (bf16_t*)out; bf16_t* const XB = (bf16_t*)(ws + WS_XB); bf16_t* const SB = (bf16_t*)out + DM; bf16_t* const R = (bf16_t*)(ws + WS_R); bf16_t* const SGB = (bf16_t*)(ws + WS_SGB);
        if (pn < 16) {
            const int chl = 16 * c.wc + 4 * c.fq, chg = 64 * pn + chl;
            PG8_LAS float* UT = (PG8_LAS float*)c.xl;
#pragma unroll
            for (int ai = 0; ai < 2; ++ai) { const f32x4 u3 = acc[ai][0][3][0] * acc[ai][0][3][1];
                if (c.fr >= 14) *(PG8_LAS f32x4*)(UT + (((ai * 2 + c.wr) * 2 + (c.fr - 14)) * 64 + chl)) = u3; }
            asm volatile("s_waitcnt lgkmcnt(0)" ::: "memory"); __builtin_amdgcn_s_barrier(); asm volatile("" ::: "memory");
            const float* cw = (const float*)(ws + WS_CW);
            const f32x4 w0 = *(const f32x4*)(cw + chg), w1 = *(const f32x4*)(cw + DM + chg), w2 = *(const f32x4*)(cw + 2 * DM + chg), cb = *(const f32x4*)(cw + 3 * DM + chg);
            const bool samp = u.pm >= MP / BM;
            float* const side = (float*)(ws + WS_SIDE) + (size_t)u.pm * 6 * DM + chg;
#pragma unroll
            for (int ai = 0; ai < 2; ++ai) {
                f32x4 uprev = (f32x4){0.f, 0.f, 0.f, 0.f};
#pragma unroll
                for (int m = 0; m < 4; ++m) { const int r = rowb + ai * HALF + m * 16;
                    const f32x4 uu = acc[ai][0][m][0] * acc[ai][0][m][1], qq = acc[ai][1][m][0] * silu4(acc[ai][1][m][1]);
                    f32x4 e1, e2;
                    if (samp && (m & 1) == 0) {
                        const int st = (u.pm - MP / BM) * 8 + ((ai * HALF + c.wr * 64 + m * 16) >> 5);
                        const bf16_t* hc = (const bf16_t*)(ws + WS_HC) + (size_t)st * 2 * DM + chg;
                        const u32x2 g2 = *(const u32x2*)hc, g1 = *(const u32x2*)(hc + DM);
                        const f32x4 h2 = (f32x4){bf_lo(g2.x), bf_hi(g2.x), bf_lo(g2.y), bf_hi(g2.y)}, h1 = (f32x4){bf_lo(g1.x), bf_hi(g1.x), bf_lo(g1.y), bf_hi(g1.y)};
                        e1 = h1; e2 = c.fr == 0 ? h2 : h1;
                    } else if (m == 0) {
                        if (c.wr == 1 || ai == 1) { const int pred = c.wr == 1 ? ai * 2 : 1;
                            const f32x4 p2 = *(const PG8_LAS f32x4*)(UT + ((pred * 2 + 0) * 64 + chl)), p1 = *(const PG8_LAS f32x4*)(UT + ((pred * 2 + 1) * 64 + chl));
                            e1 = p1; e2 = c.fr == 0 ? p2 : p1; }
                        else { e1 = (f32x4){0.f, 0.f, 0.f, 0.f}; e2 = e1; }
                    } else { e1 = dpp_ror4(uprev, 1); e2 = dpp_ror4(uprev, 2); }
                    const f32x4 um1 = dpp_shr4(e1, uu, 1), um2 = dpp_shr4(e2, uu, 2);
                    const f32x4 av = qq * (cb + w0 * um2 + w1 * um1 + w2 * uu);
                    *(u32x2*)(AB + (size_t)r * (2 * DM) + chg) = pack4(av);
                    { bool sp; const int ti = tail_idx(r, 2, sp); if (ti >= 0) *(f32x4*)(out + (sp ? O_NCS : O_NCP) + (size_t)ti * DM + chg) = uu; }
                    if (!samp) {
                        if (ai == 0 && m == 0 && c.wr == 0 && c.fr < 2) { *(f32x4*)(side + (2 + c.fr) * DM) = uu; *(f32x4*)(side + (4 + c.fr) * DM) = qq; }
                        if (ai == 1 && m == 3 && c.wr == 1 && c.fr >= 14) *(f32x4*)(side + (c.fr - 14) * DM) = uu; }
                    uprev = uu; }
            }
        } else if (pn >= 24) {
            const int ch = (pn & 7) * HALF + c.wc * 32 + 8 * c.fq;
#pragma unroll
            for (int ai = 0; ai < 2; ++ai)
#pragma unroll
                for (int m = 0; m < 4; ++m) { const int r = rowb + ai * HALF + m * 16; const size_t off = (size_t)r * DM + ch;
                    const f32x4 a0 = acc[ai][0][m][0], a1 = acc[ai][0][m][1], b0 = acc[ai][1][m][0], b1 = acc[ai][1][m][1];
                    f32x4 ea0, ea1, eb0, eb1;
#pragma unroll
                    for (int j = 0; j < 4; ++j) { ea0[j] = 1.f + expneg(a0[j]); ea1[j] = 1.f + expneg(a1[j]); eb0[j] = 1.f + expneg(b0[j]); eb1[j] = 1.f + expneg(b1[j]); }
                    f32x4 r0, r1, s0, s1;
#pragma unroll
                    for (int j = 0; j < 4; ++j) { r0[j] = eb0[j] * __builtin_amdgcn_rcpf(ea0[j]); r1[j] = eb1[j] * __builtin_amdgcn_rcpf(ea1[j]); s0[j] = __builtin_amdgcn_rcpf(eb0[j]); s1[j] = __builtin_amdgcn_rcpf(eb1[j]); }
                    *(u32x4*)(R + off) = pack8(r0, r1); *(u32x4*)(SGB + off) = pack8(s0, s1); }
        } else {
            const int ch = (pn & 3) * BM + c.wc * 32 + 8 * c.fq;
#pragma unroll
            for (int ai = 0; ai < 2; ++ai)
#pragma unroll
                for (int m = 0; m < 4; ++m) { const int r = rowb + ai * HALF + m * 16; const size_t off = (size_t)r * DM + ch, off2 = (size_t)r * (2 * DM) + ch;
                    if (pn < 20) { bool samp; const int ti = tail_idx(r, 15, samp);
#pragma unroll
                        for (int bj = 0; bj < 2; ++bj) { *(u32x4*)(XB + off + bj * HALF) = pack8(acc[ai][bj][m][0], acc[ai][bj][m][1]);
                            if (ti >= 0) { float* d = out + (samp ? O_NPS : O_NPP) + (size_t)ti * DM + ch + bj * HALF; *(f32x4*)d = acc[ai][bj][m][0]; *(f32x4*)(d + 4) = acc[ai][bj][m][1]; } } }
                    else {
#pragma unroll
                        for (int bj = 0; bj < 2; ++bj) *(u32x4*)(SB + off2 + bj * HALF) = pack8(silu4(acc[ai][bj][m][0]), silu4(acc[ai][bj][m][1])); } }
        }
    }
};

struct EpiG2 {
    static constexpr bool SEG = false, STAGED = true;
    bf16_t* SB; const float* ps;
    __device__ __forceinline__ void fin(f32x4 (&acc)[2][2][4][2], const Unit& u, const EpiCtx& c) const {
        const int row0 = u.pm * BM + c.wr * 64 + c.fr, col0 = u.pn * BM + c.wc * 32 + 8 * c.fq;
        f32x4 pv[2][2];
#pragma unroll
        for (int bj = 0; bj < 2; ++bj)
#pragma unroll
            for (int n = 0; n < 2; ++n) pv[bj][n] = *(const f32x4*)(ps + col0 + bj * HALF + 4 * n);
#pragma unroll
        for (int ai = 0; ai < 2; ++ai)
#pragma unroll
            for (int m = 0; m < 4; ++m) { const size_t off = (size_t)(row0 + ai * HALF + m * 16) * (2 * DM) + col0;
#pragma unroll
                for (int bj = 0; bj < 2; ++bj) { f32x4 s0, s1; unpack8(*(const u32x4*)(SB + off + bj * HALF), s0, s1);
                    *(u32x4*)(SB + off + bj * HALF) = pack8(acc[ai][bj][m][0] * pv[bj][0] * s0, acc[ai][bj][m][1] * pv[bj][1] * s1); } }
    }
    __device__ __forceinline__ void fin_staged(f32x4 (&acc)[2][2][4][2], const Unit& u, const EpiCtx& c) const {
        const int row0 = u.pm * BM + c.wr * 64 + c.fr, col0 = u.pn * BM + c.wc * 32 + 8 * c.fq;
        PG8_LAS unsigned char* slice = c.ring + c.wid * 16384;
#pragma unroll
        for (int ai = 0; ai < 2; ++ai)
#pragma unroll
            for (int m = 0; m < 4; ++m)
#pragma unroll
                for (int bj = 0; bj < 2; ++bj) PG8_GLDS16(SB + (size_t)(row0 + ai * HALF + m * 16) * (2 * DM) + col0 + bj * HALF, slice, ai * 8 + m * 2 + bj);
        f32x4 pv[2][2];
#pragma unroll
        for (int bj = 0; bj < 2; ++bj)
#pragma unroll
            for (int n = 0; n < 2; ++n) pv[bj][n] = *(const f32x4*)(ps + col0 + bj * HALF + 4 * n);
        asm volatile("s_waitcnt vmcnt(0)" ::: "memory");
#pragma unroll
        for (int ai = 0; ai < 2; ++ai)
#pragma unroll
            for (int m = 0; m < 4; ++m) { const size_t off = (size_t)(row0 + ai * HALF + m * 16) * (2 * DM) + col0;
#pragma unroll
                for (int bj = 0; bj < 2; ++bj) { f32x4 s0, s1; unpack8(PG8_LDSRD16(slice, ai * 8 + m * 2 + bj, c.lane), s0, s1);
                    *(u32x4*)(SB + off + bj * HALF) = pack8(acc[ai][bj][m][0] * pv[bj][0] * s0, acc[ai][bj][m][1] * pv[bj][1] * s1); } }
    }
};

struct EpiG34 {
    static constexpr bool SEG = true, STAGED = false;
    const bf16_t *R, *SGB; bf16_t* Mm;
    static constexpr bool ZERO_AFTER_MID = false;
    __device__ __forceinline__ void mid(f32x4 (&acc)[2][2][4][2], const Unit& u, const EpiCtx& c) const {
        const int row0 = u.pm * BM + c.wr * 64 + c.fr, col0 = u.pn * BM + c.wc * 32 + 8 * c.fq;
#pragma unroll
        for (int ai = 0; ai < 2; ++ai)
#pragma unroll
            for (int m = 0; m < 4; ++m) { const size_t off = (size_t)(row0 + ai * HALF + m * 16) * DM + col0;
#pragma unroll
                for (int bj = 0; bj < 2; ++bj) { f32x4 s0, s1; unpack8(*(const u32x4*)(R + off + bj * HALF), s0, s1); acc[ai][bj][m][0] *= s0; acc[ai][bj][m][1] *= s1; } }
    }
    __device__ __forceinline__ void fin(f32x4 (&acc)[2][2][4][2], const Unit& u, const EpiCtx& c) const {
        const int row0 = u.pm * BM + c.wr * 64 + c.fr, col0 = u.pn * BM + c.wc * 32 + 8 * c.fq;
#pragma unroll
        for (int ai = 0; ai < 2; ++ai)
#pragma unroll
            for (int m = 0; m < 4; ++m) { const size_t off = (size_t)(row0 + ai * HALF + m * 16) * DM + col0;
#pragma unroll
                for (int bj = 0; bj < 2; ++bj) { f32x4 s0, s1; unpack8(*(const u32x4*)(SGB + off + bj * HALF), s0, s1);
                    *(u32x4*)(Mm + off + bj * HALF) = pack8(acc[ai][bj][m][0] * s0, acc[ai][bj][m][1] * s1); } }
    }
    __device__ __forceinline__ void fin_staged(f32x4 (&acc)[2][2][4][2], const Unit& u, const EpiCtx& c) const {
        const int row0 = u.pm * BM + c.wr * 64 + c.fr, col0 = u.pn * BM + c.wc * 32 + 8 * c.fq;
        PG8_LAS unsigned char* slice = c.ring + c.wid * 16384;
#pragma unroll
        for (int ai = 0; ai < 2; ++ai)
#pragma unroll
            for (int m = 0; m < 4; ++m)
#pragma unroll
                for (int bj = 0; bj < 2; ++bj) PG8_GLDS16(SGB + (size_t)(row0 + ai * HALF + m * 16) * DM + col0 + bj * HALF, slice, ai * 8 + m * 2 + bj);
        asm volatile("s_waitcnt vmcnt(0)" ::: "memory");
#pragma unroll
        for (int ai = 0; ai < 2; ++ai)
#pragma unroll
            for (int m = 0; m < 4; ++m) { const size_t off = (size_t)(row0 + ai * HALF + m * 16) * DM + col0;
#pragma unroll
                for (int bj = 0; bj < 2; ++bj) { f32x4 s0, s1; unpack8(PG8_LDSRD16(slice, ai * 8 + m * 2 + bj, c.lane), s0, s1);
                    *(u32x4*)(Mm + off + bj * HALF) = pack8(acc[ai][bj][m][0] * s0, acc[ai][bj][m][1] * s1); } }
    }
};

struct EpiG5 {
    static constexpr bool SEG = false, STAGED = true;
    const float *xp, *xs, *gpost; float* Y; bf16_t* X1b; float* slots; unsigned* cnt; unsigned* tmo;
    __device__ __forceinline__ void exchange(f32x4 (&acc)[2][2][4][2], const Unit& u, const EpiCtx& c) const {
        PG8_LAS float* P = (PG8_LAS float*)c.xl;
        PG8_LAS float* S = (PG8_LAS float*)(c.xl + 4096);
        PG8_LAS unsigned* flag = (PG8_LAS unsigned*)(c.xl + 4096 + 1024);
#pragma unroll
        for (int ai = 0; ai < 2; ++ai)
#pragma unroll
            for (int m = 0; m < 4; ++m) { float s = 0.f;
#pragma unroll
                for (int bj = 0; bj < 2; ++bj)
#pragma unroll
                    for (int n = 0; n < 2; ++n) { const f32x4 x = acc[ai][bj][m][n]; s += (x[0] * x[0] + x[1] * x[1]) + (x[2] * x[2] + x[3] * x[3]); }
                { const auto r16 = __builtin_amdgcn_permlane16_swap(__float_as_uint(s), __float_as_uint(s), false, false); s = __uint_as_float(r16[0]) + __uint_as_float(r16[1]); }
                { const auto r32 = __builtin_amdgcn_permlane32_swap(__float_as_uint(s), __float_as_uint(s), false, false); s = __uint_as_float(r32[0]) + __uint_as_float(r32[1]); }
                if (c.fq == 0) P[(ai * HALF + c.wr * 64 + m * 16 + c.fr) * 4 + c.wc] = s; }
        asm volatile("s_waitcnt lgkmcnt(0)" ::: "memory"); __builtin_amdgcn_s_barrier(); asm volatile("" ::: "memory");
        const int row = c.wid * 32 + (c.lane & 31);
        if (c.lane < 32) { const float tot = (P[row * 4 + 0] + P[row * 4 + 1]) + (P[row * 4 + 2] + P[row * 4 + 3]);
            __hip_atomic_store((unsigned*)slots + ((size_t)(u.pm * BM + row) * 4 + u.pn), __float_as_uint(tot), __ATOMIC_RELAXED, __HIP_MEMORY_SCOPE_AGENT); }
        asm volatile("s_waitcnt vmcnt(0)" ::: "memory");
        if (c.lane == 0) __hip_atomic_fetch_add(cnt + 64 * u.pm, 1u, __ATOMIC_RELAXED, __HIP_MEMORY_SCOPE_AGENT);
        if (c.wid == 0) { bool dead = false; unsigned spins = 0;
            for (;;) {
                if ((unsigned)__builtin_amdgcn_readfirstlane(__hip_atomic_load(cnt + 64 * u.pm, __ATOMIC_RELAXED, __HIP_MEMORY_SCOPE_AGENT)) >= 32u) break;
                if (++spins > (1u << 18)) { if (c.lane == 0) __hip_atomic_store(tmo, 1u, __ATOMIC_RELAXED, __HIP_MEMORY_SCOPE_AGENT); dead = true; break; }
                __builtin_amdgcn_s_sleep(2); }
            __builtin_amdgcn_fence(__ATOMIC_ACQUIRE, "agent");
            if (c.lane == 0) flag[0] = dead ? 1u : 0u; }
        asm volatile("s_waitcnt vmcnt(0) lgkmcnt(0)" ::: "memory"); __builtin_amdgcn_s_barrier(); asm volatile("" ::: "memory");
        if (c.lane < 32) { const unsigned* sl = (const unsigned*)slots + (size_t)(u.pm * BM + row) * 4; float q = 0.f;
#pragma unroll
            for (int t = 0; t < 4; ++t) q += __uint_as_float(__hip_atomic_load(sl + t, __ATOMIC_RELAXED, __HIP_MEMORY_SCOPE_AGENT));
            S[row] = 1.0f / sqrtf(q * (1.0f / DM) + EPS); }
        asm volatile("s_waitcnt lgkmcnt(0)" ::: "memory"); __builtin_amdgcn_s_barrier(); asm volatile("" ::: "memory");
    }
    __device__ __forceinline__ void fin(f32x4 (&acc)[2][2][4][2], const Unit& u, const EpiCtx& c) const {
        exchange(acc, u, c);
        const PG8_LAS float* S = (const PG8_LAS float*)(c.xl + 4096);
        const int row0 = u.pm * BM + c.wr * 64 + c.fr, col0 = u.pn * BM + c.wc * 32 + 8 * c.fq;
        const float* xb = (u.pm * BM < MP) ? xp : xs - (size_t)MP * DM;
        f32x4 gv[2][2];
#pragma unroll
        for (int bj = 0; bj < 2; ++bj)
#pragma unroll
            for (int n = 0; n < 2; ++n) gv[bj][n] = *(const f32x4*)(gpost + col0 + bj * HALF + 4 * n);
#pragma unroll
        for (int ai = 0; ai < 2; ++ai)
#pragma unroll
            for (int m = 0; m < 4; ++m) { const int rl = ai * HALF + c.wr * 64 + m * 16 + c.fr; const float rs = S[rl]; const size_t off = (size_t)(row0 + ai * HALF + m * 16) * DM + col0;
#pragma unroll
                for (int bj = 0; bj < 2; ++bj) { const f32x4 x0 = *(const f32x4*)(xb + off + bj * HALF), x1 = *(const f32x4*)(xb + off + bj * HALF + 4);
                    const f32x4 o0 = x0 + acc[ai][bj][m][0] * rs * gv[bj][0], o1 = x1 + acc[ai][bj][m][1] * rs * gv[bj][1];
                    *(u32x4*)(X1b + (size_t)(row0 + ai * HALF + m * 16) * XPLD + col0 + bj * HALF) = pack8(o0, o1); }
                if (m & 1) asm volatile("" ::: "memory"); }
    }
    __device__ __forceinline__ void fin_staged(f32x4 (&acc)[2][2][4][2], const Unit& u, const EpiCtx& c) const {
        const int row0 = u.pm * BM + c.wr * 64 + c.fr, col0 = u.pn * BM + c.wc * 32 + 8 * c.fq;
        const float* xb = (u.pm * BM < MP) ? xp : xs - (size_t)MP * DM;
        PG8_LAS unsigned char* slice = c.ring + c.wid * 16384;
#pragma unroll
        for (int m = 0; m < 4; ++m)
#pragma unroll
            for (int bj = 0; bj < 2; ++bj)
#pragma unroll
                for (int q = 0; q < 2; ++q) PG8_GLDS16(xb + (size_t)(row0 + m * 16) * DM + col0 + bj * HALF + 4 * q, slice, m * 4 + bj * 2 + q);
        exchange(acc, u, c);
        const PG8_LAS float* S = (const PG8_LAS float*)(c.xl + 4096);
        f32x4 gv[2][2];
#pragma unroll
        for (int bj = 0; bj < 2; ++bj)
#pragma unroll
            for (int n = 0; n < 2; ++n) gv[bj][n] = *(const f32x4*)(gpost + col0 + bj * HALF + 4 * n);
#pragma unroll
        for (int ai = 0; ai < 2; ++ai) {
            asm volatile("s_waitcnt vmcnt(0)" ::: "memory");
            f32x4 xr[4][2][2];
#pragma unroll
            for (int m = 0; m < 4; ++m)
#pragma unroll
                for (int bj = 0; bj < 2; ++bj)
#pragma unroll
                    for (int q = 0; q < 2; ++q) xr[m][bj][q] = PG8_LDSRDF4(slice, m * 4 + bj * 2 + q, c.lane);
            if (ai == 0) { asm volatile("s_waitcnt lgkmcnt(0)" ::: "memory");
#pragma unroll
                for (int m = 0; m < 4; ++m)
#pragma unroll
                    for (int bj = 0; bj < 2; ++bj)
#pragma unroll
                        for (int q = 0; q < 2; ++q) PG8_GLDS16(xb + (size_t)(row0 + HALF + m * 16) * DM + col0 + bj * HALF + 4 * q, slice, m * 4 + bj * 2 + q); }
#pragma unroll
            for (int m = 0; m < 4; ++m) { const float rs = S[ai * HALF + c.wr * 64 + m * 16 + c.fr];
#pragma unroll
                for (int bj = 0; bj < 2; ++bj) { const f32x4 o0 = xr[m][bj][0] + acc[ai][bj][m][0] * rs * gv[bj][0], o1 = xr[m][bj][1] + acc[ai][bj][m][1] * rs * gv[bj][1];
                    *(u32x4*)(X1b + (size_t)(row0 + ai * HALF + m * 16) * XPLD + col0 + bj * HALF) = pack8(o0, o1); } }
        }
    }
};

struct EpiG6 {
    static constexpr bool SEG = true, ZERO_AFTER_MID = true, STAGED = true;
    float* Y; bf16_t* E; const bf16_t* X1b;
    __device__ __forceinline__ void mid(f32x4 (&acc)[2][2][4][2], const Unit& u, const EpiCtx& c) const {
        const int row0 = u.pm * BM + c.wr * 64 + c.fr, col0 = u.pn * BM + c.wc * 32 + 8 * c.fq;
#pragma unroll
        for (int ai = 0; ai < 2; ++ai)
#pragma unroll
            for (int m = 0; m < 4; ++m) { bf16_t* rowp = E + (size_t)(row0 + ai * HALF + m * 16) * DM + col0;
#pragma unroll
                for (int bj = 0; bj < 2; ++bj) *(u32x4*)(rowp + bj * HALF) = pack8(acc[ai][bj][m][0], acc[ai][bj][m][1]); }
    }
    __device__ __forceinline__ void fin(f32x4 (&acc)[2][2][4][2], const Unit& u, const EpiCtx& c) const {
        const int row0 = u.pm * BM + c.wr * 64 + c.fr, col0 = u.pn * BM + c.wc * 32 + 8 * c.fq;
#pragma unroll
        for (int ai = 0; ai < 2; ++ai)
#pragma unroll
            for (int m = 0; m < 4; ++m) { const size_t off = (size_t)(row0 + ai * HALF + m * 16) * DM + col0;
#pragma unroll
                for (int bj = 0; bj < 2; ++bj) { f32x4 x0, x1; unpack8(*(const u32x4*)(X1b + (size_t)(row0 + ai * HALF + m * 16) * XPLD + col0 + bj * HALF), x0, x1);
                    f32x4 e0, e1; unpack8(*(const u32x4*)(E + off + bj * HALF), e0, e1);
                    *(f32x4*)(Y + off + bj * HALF) = x0 + e0 * sigm4(acc[ai][bj][m][0]); *(f32x4*)(Y + off + bj * HALF + 4) = x1 + e1 * sigm4(acc[ai][bj][m][1]); }
                if (m & 1) asm volatile("" ::: "memory"); }
    }
    __device__ __forceinline__ void fin_staged(f32x4 (&acc)[2][2][4][2], const Unit& u, const EpiCtx& c) const {
        const int row0 = u.pm * BM + c.wr * 64 + c.fr, col0 = u.pn * BM + c.wc * 32 + 8 * c.fq;
        PG8_LAS unsigned char* slice = c.ring + c.wid * 16384;
#pragma unroll
        for (int ai = 0; ai < 2; ++ai) {
            if (ai == 0) {
#pragma unroll
                for (int m = 0; m < 4; ++m)
#pragma unroll
                    for (int bj = 0; bj < 2; ++bj) { const int r = row0 + m * 16;
                        PG8_GLDS16(X1b + (size_t)r * XPLD + col0 + bj * HALF, slice, m * 4 + bj * 2); PG8_GLDS16(E + (size_t)r * DM + col0 + bj * HALF, slice, m * 4 + bj * 2 + 1); } }
            asm volatile("s_waitcnt vmcnt(0)" ::: "memory");
            u32x4 xr[4][2], er[4][2];
#pragma unroll
            for (int m = 0; m < 4; ++m)
#pragma unroll
                for (int bj = 0; bj < 2; ++bj) { xr[m][bj] = PG8_LDSRD16(slice, m * 4 + bj * 2, c.lane); er[m][bj] = PG8_LDSRD16(slice, m * 4 + bj * 2 + 1, c.lane); }
            if (ai == 0) { asm volatile("s_waitcnt lgkmcnt(0)" ::: "memory");
#pragma unroll
                for (int m = 0; m < 4; ++m)
#pragma unroll
                    for (int bj = 0; bj < 2; ++bj) { const int r = row0 + HALF + m * 16;
                        PG8_GLDS16(X1b + (size_t)r * XPLD + col0 + bj * HALF, slice, m * 4 + bj * 2); PG8_GLDS16(E + (size_t)r * DM + col0 + bj * HALF, slice, m * 4 + bj * 2 + 1); } }
#pragma unroll
            for (int m = 0; m < 4; ++m) { const size_t off = (size_t)(row0 + ai * HALF + m * 16) * DM + col0;
#pragma unroll
                for (int bj = 0; bj < 2; ++bj) { f32x4 x0, x1, e0, e1; unpack8(xr[m][bj], x0, x1); unpack8(er[m][bj], e0, e1);
                    *(f32x4*)(Y + off + bj * HALF) = x0 + e0 * sigm4(acc[ai][bj][m][0]); *(f32x4*)(Y + off + bj * HALF + 4) = x1 + e1 * sigm4(acc[ai][bj][m][1]); } }
        }
    }
};

template <class Epi, class Sched>
__device__ __forceinline__ void gemm_phase(PG8_LAS unsigned char* lds, PG8_LAS unsigned char* xl, const int wid_in, const Gemm g, const Sched& S, const Epi& E) {
    int wid_ = wid_in; asm volatile("" : "+s"(wid_)); const int wid = wid_;
    int lane_ = (int)__builtin_amdgcn_mbcnt_hi(~0u, __builtin_amdgcn_mbcnt_lo(~0u, 0u)); asm volatile("" : "+v"(lane_));
    const int lane = lane_, tid = wid * 64 + lane, wr = wid >> 2, wc = wid & 3, fr = lane & 15, fq = lane >> 4;
    unsigned voffA, voffB;
    { int R, C; stage_rc(tid * 16, R, C); const int Rb = (R & ~31) + perm32(R & 31); voffA = (unsigned)(R * g.lda + C) * 2u; voffB = (unsigned)(Rb * g.ldb + C) * 2u; }
    const size_t p2A = (size_t)64 * g.lda * 2, p2B = (size_t)64 * g.ldb * 2;
    const size_t kstep = (size_t)(BK * 2);
    const size_t hstepA = (size_t)HALF * g.lda * 2, hstepB = (size_t)HALF * g.ldb * 2;
    const unsigned ldsw = (unsigned)wid * 1024u;
    const int aoff = lds_byte(wr * 64 + fr, fq * 8), boff = lds_byte(wc * 32 + fr, fq * 8);
    EpiCtx ctx; ctx.wr = wr; ctx.wc = wc; ctx.fr = fr; ctx.fq = fq; ctx.wid = wid; ctx.lane = lane; ctx.xl = xl; ctx.ring = lds;
#define PG8_UA(u) ((const char*)g.A + ((long)(u).pm * BM * g.lda + (long)(u).pn * g.acol + (long)((u).seg ? g.ao1 : g.ao0)) * 2)
#define PG8_UB(u) ((const char*)g.Bt + ((long)(u).pn * BM * g.ldb + (long)((u).seg ? g.bo1 : g.bo0)) * 2)
#define PG8_SA(b, h) (((b) * 2 + (h)) * HTB)
#define PG8_SB(b, h) ((4 + (b) * 2 + (h)) * HTB)
#define PG8_STAGE(bufoff, gbase, voff) do { \
        __builtin_amdgcn_global_load_lds((const unsigned*)((const char*)(gbase) + (voff)), (PG8_LAS unsigned*)(lds + (bufoff) + ldsw), 16, 0, 0); \
        __builtin_amdgcn_global_load_lds((const unsigned*)((const char*)(gbase) + (&(voff) == &voffA ? p2A : p2B) + (voff)), (PG8_LAS unsigned*)(lds + (bufoff) + ldsw + 8192), 16, 0, 0); } while (0)
#define PG8_LDA(dst, b, h) do { _Pragma("unroll") for (int m = 0; m < 4; ++m) _Pragma("unroll") for (int k = 0; k < 2; ++k) dst[m][k] = *(const PG8_LAS bf16x8*)(lds + PG8_SA(b, h) + aoff + m * 2048 + k * 1024); } while (0)
#define PG8_LDB(dst, b, h) do { _Pragma("unroll") for (int n = 0; n < 2; ++n) _Pragma("unroll") for (int k = 0; k < 2; ++k) dst[n][k] = *(const PG8_LAS bf16x8*)(lds + PG8_SB(b, h) + boff + n * 2048 + k * 1024); } while (0)
#define PG8_MMA(ai, bj, At, Bt) do { __builtin_amdgcn_s_setprio(1); _Pragma("unroll") for (int m = 0; m < 4; ++m) _Pragma("unroll") for (int n = 0; n < 2; ++n) _Pragma("unroll") for (int k = 0; k < 2; ++k) \
        acc[ai][bj][m][n] = __builtin_amdgcn_mfma_f32_16x16x32_bf16(Bt[n][k], At[m][k], acc[ai][bj][m][n], 0, 0, 0); __builtin_amdgcn_s_setprio(0); } while (0)
#define PG8_WAIT_V(n) asm volatile("s_waitcnt vmcnt(" #n ")" ::: "memory")
#define PG8_WAIT_L(n) asm volatile("s_waitcnt lgkmcnt(" #n ")" ::: "memory")
#define PG8_BAR __builtin_amdgcn_s_barrier()
#define PG8_SCHED __builtin_amdgcn_sched_barrier(0)
    Unit cur, nxt; int ui = 0;
    if (!S.next(0, cur)) return;
    f32x4 acc[2][2][4][2];
#pragma unroll
    for (int a = 0; a < 2; ++a)
#pragma unroll
        for (int b = 0; b < 2; ++b)
#pragma unroll
            for (int m = 0; m < 4; ++m)
#pragma unroll
                for (int n = 0; n < 2; ++n) acc[a][b][m][n] = (f32x4){0.f, 0.f, 0.f, 0.f};
    bf16x8 At[4][2], B0[2][2], B1[2][2];
    const char* cA = PG8_UA(cur); const char* cB = PG8_UB(cur);
    PG8_STAGE(PG8_SB(0, 0), cB, voffB); PG8_STAGE(PG8_SB(0, 1), cB + hstepB, voffB); PG8_STAGE(PG8_SA(0, 0), cA, voffA); PG8_STAGE(PG8_SA(0, 1), cA + hstepA, voffA);
    if (wr == 1) PG8_BAR;
    PG8_WAIT_V(2); PG8_BAR;
    PG8_STAGE(PG8_SB(1, 0), cB + kstep, voffB); PG8_STAGE(PG8_SA(1, 0), cA + kstep, voffA); PG8_STAGE(PG8_SB(1, 1), cB + hstepB + kstep, voffB);
    PG8_WAIT_V(6); PG8_BAR;
    for (;;) {
        const bool has_next = S.next(ui + 1, nxt);
        const char* nA = has_next ? PG8_UA(nxt) : cA; const char* nB = has_next ? PG8_UB(nxt) : cB;
        const int nt = cur.seg ? g.nt1 : g.nt0;
        for (int t = 0; t < nt; t += 2) {
            const bool last = (t == nt - 2);
            const char* a1 = cA + (size_t)(t + 1) * kstep;
            const char* a2 = last ? nA : cA + (size_t)(t + 2) * kstep; const char* b2 = last ? nB : cB + (size_t)(t + 2) * kstep;
            const char* a3 = a2 + kstep; const char* b3 = b2 + kstep;
            PG8_LDB(B0, 0, 0); PG8_LDB(B1, 0, 1); PG8_SCHED; PG8_LDA(At, 0, 0); PG8_STAGE(PG8_SA(1, 1), a1 + hstepA, voffA);
            PG8_WAIT_V(8); PG8_WAIT_L(0); PG8_BAR; PG8_MMA(0, 0, At, B0); PG8_MMA(0, 1, At, B1); PG8_BAR; PG8_SCHED;
            PG8_LDA(At, 0, 1); PG8_STAGE(PG8_SB(0, 0), b2, voffB); PG8_STAGE(PG8_SB(0, 1), b2 + hstepB, voffB); PG8_STAGE(PG8_SA(0, 0), a2, voffA);
            PG8_WAIT_V(8); PG8_WAIT_L(0); PG8_BAR; PG8_MMA(1, 0, At, B0); PG8_MMA(1, 1, At, B1); PG8_BAR; PG8_SCHED;
            PG8_LDB(B0, 1, 0); PG8_LDB(B1, 1, 1); PG8_SCHED; PG8_LDA(At, 1, 0); PG8_STAGE(PG8_SA(0, 1), a2 + hstepA, voffA);
            PG8_WAIT_V(8); PG8_WAIT_L(0); PG8_BAR; PG8_MMA(0, 0, At, B0); PG8_MMA(0, 1, At, B1); PG8_BAR; PG8_SCHED;
            PG8_LDA(At, 1, 1); PG8_STAGE(PG8_SB(1, 0), b3, voffB); PG8_STAGE(PG8_SB(1, 1), b3 + hstepB, voffB); PG8_STAGE(PG8_SA(1, 0), a3, voffA);
            PG8_WAIT_V(8); PG8_WAIT_L(0); PG8_BAR; PG8_MMA(1, 0, At, B0); PG8_MMA(1, 1, At, B1); PG8_BAR; PG8_SCHED;
        }
        if (wr == 0) PG8_BAR;
        bool zero = true;
        { int le = (int)__builtin_amdgcn_mbcnt_hi(~0u, __builtin_amdgcn_mbcnt_lo(~0u, 0u)); asm volatile("" : "+v"(le)); ctx.lane = le; ctx.fr = le & 15; ctx.fq = le >> 4; }
        const bool defer = Epi::STAGED && !has_next;
        if constexpr (Epi::SEG) { if (cur.seg == 0) { E.mid(acc, cur, ctx); zero = Epi::ZERO_AFTER_MID; } else if (!defer) E.fin(acc, cur, ctx); }
        else { if (!defer) E.fin(acc, cur, ctx); }
        if (!has_next) break;
        if (zero) {
#pragma unroll
            for (int a = 0; a < 2; ++a)
#pragma unroll
                for (int b = 0; b < 2; ++b)
#pragma unroll
                    for (int m = 0; m < 4; ++m)
#pragma unroll
                        for (int n = 0; n < 2; ++n) acc[a][b][m][n] = (f32x4){0.f, 0.f, 0.f, 0.f};
        }
        cur = nxt; cA = nA; cB = nB; ++ui;
        if (wr == 1) PG8_BAR;
    }
    PG8_WAIT_V(0);
    PG8_BAR;
    if constexpr (Epi::STAGED) {
        { int le = (int)__builtin_amdgcn_mbcnt_hi(~0u, __builtin_amdgcn_mbcnt_lo(~0u, 0u)); asm volatile("" : "+v"(le)); ctx.lane = le; ctx.fr = le & 15; ctx.fq = le >> 4; }
        E.fin_staged(acc, cur, ctx);
    }
#undef PG8_UA
#undef PG8_UB
#undef PG8_SA
#undef PG8_SB
#undef PG8_STAGE
#undef PG8_LDA
#undef PG8_LDB
#undef PG8_MMA
#undef PG8_WAIT_V
#undef PG8_WAIT_L
#undef PG8_BAR
#undef PG8_SCHED
}
}

constexpr int RING_BYTES = 131072;
constexpr int XL_OFF = RING_BYTES;
constexpr int MISC_OFF = XL_OFF + 8192;
constexpr int LDS_BYTES = 147456;
static_assert(MISC_OFF + 128 <= LDS_BYTES, "LDS map");

#define GAS __attribute__((address_space(1)))
#define LAS __attribute__((address_space(3)))
typedef unsigned short bf16;
typedef unsigned v4u __attribute__((ext_vector_type(4)));
typedef float f32x4 __attribute__((ext_vector_type(4)));
typedef GAS unsigned gu32;
#define RLX_AGENT __ATOMIC_RELAXED, __HIP_MEMORY_SCOPE_AGENT
#define LDS_WAIT() asm volatile("s_waitcnt lgkmcnt(0)" ::: "memory")
#define VM_WAIT() asm volatile("s_waitcnt vmcnt(0)" ::: "memory")
__device__ __forceinline__ unsigned f2bf(float f) { unsigned u = __builtin_bit_cast(unsigned, f); return (u + 0x7fffu + ((u >> 16) & 1u)) >> 16; }
__device__ __forceinline__ unsigned pk2(float lo, float hi) { return f2bf(lo) | (f2bf(hi) << 16); }

#define XB_TMO      128
#define XB_XCNT(j)  (256  + 64 * (j))
#define XB_XSUB(j)  (1280 + 64 * (j))
#define XB_XGEN(j)  (2304 + 64 * (j))
#define XB_TOP      3328
#define XB_TOPGEN   3392
#define XCD_BAR_WORDS 3456
#define XB_SPIN_CAP (1u << 18)
__device__ __forceinline__ unsigned xb_ld(unsigned* p)              { return __hip_atomic_load(p, __ATOMIC_RELAXED, __HIP_MEMORY_SCOPE_AGENT); }
__device__ __forceinline__ unsigned xb_add(unsigned* p, unsigned v) { return __hip_atomic_fetch_add(p, v, __ATOMIC_RELAXED, __HIP_MEMORY_SCOPE_AGENT); }
__device__ __forceinline__ unsigned xb_xcc_id() { return (unsigned)__builtin_amdgcn_s_getreg((3 << 11) | 20) & 0xFu; }
#define XB_SPIN(cond, bar) do { unsigned _sp = 0; while (cond) { __builtin_amdgcn_s_sleep(1); \
    if ((++_sp & 255u) == 0u) { if (xb_ld(&(bar)[XB_TMO])) break; if (_sp > XB_SPIN_CAP) { atomicAdd(&(bar)[XB_TMO], 1u); break; } } } } while (0)
struct XcdBarrier { unsigned* bar; unsigned x; volatile LAS unsigned* st; };
__device__ __forceinline__ int lane_id_opaque() { int l = (int)__builtin_amdgcn_mbcnt_hi(~0u, __builtin_amdgcn_mbcnt_lo(~0u, 0u)); asm volatile("" : "+v"(l)); return l; }
#define XB_LEADER(wave) ((wave) == 0 && lane_id_opaque() == 0)
__device__ __forceinline__ XcdBarrier xcd_barrier_post(unsigned* bar, volatile LAS unsigned* st, int wave) {
    XcdBarrier b; b.bar = bar; b.x = xb_xcc_id(); b.st = st;
    if (XB_LEADER(wave)) (void)xb_add(&bar[XB_XCNT(b.x)], 1u);
    return b;
}
__device__ __forceinline__ void xcd_barrier_complete(unsigned* bar, unsigned x, unsigned& nloc, unsigned& nx) {
    const unsigned G = gridDim.x * gridDim.y * gridDim.z;
    unsigned sum, cnt, mine, sp = 0u;
    for (;;) {
        sum = 0u; cnt = 0u; mine = 0u;
#pragma unroll
        for (unsigned j = 0; j < 16; ++j) { const unsigned c = xb_ld(&bar[XB_XCNT(j)]); sum += c; cnt += (c > 0u) ? 1u : 0u; mine = (j == x) ? c : mine; }
        if (sum == G) break;
        __builtin_amdgcn_s_sleep(1);
        if ((++sp & 255u) == 0u) { if (xb_ld(&bar[XB_TMO])) break; if (sp > XB_SPIN_CAP) { atomicAdd(&bar[XB_TMO], 1u); break; } }
    }
    nloc = mine > 0u ? mine : 1u; nx = cnt > 0u ? cnt : 1u;
}
__device__ __forceinline__ void xcd_barrier(const XcdBarrier& b, int wave) {
    asm volatile("s_waitcnt vmcnt(0)" ::: "memory");
    __syncthreads();
    if (XB_LEADER(wave)) {
        unsigned* bar = b.bar;
        __builtin_amdgcn_s_waitcnt(0);
        unsigned nloc = b.st[0], nx = b.st[1];
        if (nloc == 0u) { xcd_barrier_complete(bar, b.x, nloc, nx); b.st[0] = nloc; b.st[1] = nx; }
        const unsigned old = xb_add(&bar[XB_XSUB(b.x)], 1u);
        const unsigned gen = old / nloc;
        if (old + 1u == (gen + 1u) * nloc) {
            __builtin_amdgcn_fence(__ATOMIC_RELEASE, "agent");
            asm volatile("s_waitcnt vmcnt(0)" ::: "memory");
            const unsigned og = xb_add(&bar[XB_TOP], 1u);
            const unsigned tg = og / nx;
            if (og + 1u == (tg + 1u) * nx) xb_add(&bar[XB_TOPGEN], 1u);
            else XB_SPIN(xb_ld(&bar[XB_TOPGEN]) == tg, bar);
            __builtin_amdgcn_fence(__ATOMIC_ACQUIRE, "agent");
            xb_add(&bar[XB_XGEN(b.x)], 1u);
            asm volatile("s_waitcnt vmcnt(0)" ::: "memory");
        } else {
            XB_SPIN(xb_ld(&bar[XB_XGEN(b.x)]) == gen, bar);
            __builtin_amdgcn_fence(__ATOMIC_ACQUIRE, "agent");
            asm volatile("s_waitcnt vmcnt(0)" ::: "memory");
        }
    }
    __syncthreads();
}
__device__ __forceinline__ void chain_barrier(unsigned* cnt, unsigned target, unsigned* tmo, int wave) {
    asm volatile("s_waitcnt vmcnt(0)" ::: "memory");
    __syncthreads();
    if (XB_LEADER(wave)) {
        __builtin_amdgcn_fence(__ATOMIC_RELEASE, "agent");
        asm volatile("s_waitcnt vmcnt(0)" ::: "memory");
        xb_add(cnt, 1u);
        unsigned sp = 0u;
        while (xb_ld(cnt) < target) { __builtin_amdgcn_s_sleep(1); if ((++sp & 255u) == 0u) { if (xb_ld(tmo)) break; if (sp > XB_SPIN_CAP) { atomicAdd(tmo, 1u); break; } } }
        __builtin_amdgcn_fence(__ATOMIC_ACQUIRE, "agent");
        asm volatile("s_waitcnt vmcnt(0)" ::: "memory");
    }
    __syncthreads();
}

__device__ __forceinline__ void team_barrier(unsigned* cnt, unsigned target, bool same_xcd, unsigned* tmo, int wave) {
    asm volatile("s_waitcnt vmcnt(0)" ::: "memory");
    __syncthreads();
    if (XB_LEADER(wave)) {
        if (!same_xcd) { __builtin_amdgcn_fence(__ATOMIC_RELEASE, "agent"); asm volatile("s_waitcnt vmcnt(0)" ::: "memory"); }
        xb_add(cnt, 1u);
        unsigned sp = 0u;
        while (xb_ld(cnt) < target) { __builtin_amdgcn_s_sleep(1); if ((++sp & 255u) == 0u) { if (xb_ld(tmo)) break; if (sp > XB_SPIN_CAP) { atomicAdd(tmo, 1u); break; } } }
        __builtin_amdgcn_fence(__ATOMIC_ACQUIRE, "agent");
        asm volatile("s_waitcnt vmcnt(0)" ::: "memory");
    }
    __syncthreads();
}

struct Args { const float* in[18]; float* out; unsigned char* ws; };

__device__ __forceinline__ float wave_sum(float v) {
#pragma unroll
    for (int o = 1; o < 64; o <<= 1) v += __shfl_xor(v, o);
    return v;
}
__device__ __forceinline__ int win_dest_row(int n) {
    const int seg = n >> 10, c = n & 1023;
    if (seg < 4) {
        const int chl = c & 63;
        return 256 * (c >> 6) + 128 * (seg & 1) + 32 * (chl >> 4) + 8 * ((chl >> 2) & 3) + 4 * (seg >> 1) + (chl & 3);
    }
    const int t = c >> 7, i = c & 127;
    switch (seg) {
        case 4: return 4096 + c;
        case 5: return 5120 + c;
        case 6: return 256 * (24 + t) + i;
        default: return 256 * (24 + t) + 128 + i;
    }
}
template <bool WIN>
__device__ __forceinline__ void p0_transpose_item(const float* W, int N, bf16* WT, int ldt, int koff, int row_off, LAS float* scr, int kb, int nb, int lane) {
    const int k0 = 64 * kb, n0 = 32 * nb;
    float tv[32];
#pragma unroll
    for (int i = 0; i < 32; ++i) tv[i] = __builtin_nontemporal_load(W + (size_t)(k0 + 2 * i + (lane >> 5)) * N + n0 + (lane & 31));
#pragma unroll
    for (int i = 0; i < 32; ++i) scr[(2 * i + (lane >> 5)) * 33 + (lane & 31)] = tv[i];
    LDS_WAIT(); asm volatile("" ::: "memory");
    const int c = lane & 7;
#pragma unroll
    for (int j = 0; j < 4; ++j) { const int n = (lane >> 3) + 8 * j; const LAS float* s = scr + (8 * c) * 33 + n;
        v4u o; o.x = pk2(s[0 * 33], s[1 * 33]); o.y = pk2(s[2 * 33], s[3 * 33]); o.z = pk2(s[4 * 33], s[5 * 33]); o.w = pk2(s[6 * 33], s[7 * 33]);
        *(GAS v4u*)(WT + (size_t)(WIN ? win_dest_row(n0 + n) : row_off + n0 + n) * ldt + koff + k0 + 8 * c) = o; }
    LDS_WAIT(); asm volatile("" ::: "memory");
}

#define EW_LD16(base, boff) (*(const pg8::u32x4*)((const char*)(base) + (unsigned)(boff)))
#define EW_LDF4(base, boff) (*(const f32x4*)((const char*)(base) + (unsigned)(boff)))
#define EW_ST16(base, boff, v) (*(pg8::u32x4*)((char*)(base) + (unsigned)(boff)) = (v))
template <int W>
__device__ __forceinline__ void ew_strip(int m0, int ch, const unsigned char* ws) {
    const bool samp = m0 >= MP; const int t0 = samp ? ((m0 - MP) & 31) : (m0 & (SEQ - 1)); const int sidx = samp ? (m0 - MP) >> 5 : 0;
    const int mbase = m0 - t0;
    const unsigned zoff = (unsigned)WS_ZR + (unsigned)ch * 2u;
    pg8::u32x4 xr[W - 1 + 8];
#pragma unroll
    for (int i = 0; i < W - 1 + 8; ++i) { const int t = t0 - (W - 1) + i;
        const unsigned o = t >= 0 ? (unsigned)WS_XB + (unsigned)((mbase + t) * DM + ch) * 2u : (samp ? (unsigned)WS_HP + (unsigned)((sidx * 15 + 15 + t) * DM + ch) * 2u : zoff);
        xr[i] = EW_LD16(ws, o); }
    f32x4 s0 = (f32x4){0.f, 0.f, 0.f, 0.f}, s1 = s0;
#pragma unroll
    for (int i = 0; i < W - 1; ++i) { f32x4 a, b; pg8::unpack8(xr[i], a, b); s0 += a; s1 += b; }
    const unsigned dofs = (unsigned)WS_H + (unsigned)(m0 * DM + ch) * 2u;
#pragma unroll
    for (int i = 0; i < 8; ++i) { f32x4 a, b; pg8::unpack8(xr[W - 1 + i], a, b); s0 += a; s1 += b;
        const int t = t0 + i; const float inv = 1.0f / (float)(samp ? W : (t + 1 < W ? t + 1 : W));
        EW_ST16(ws, dofs + (unsigned)i * (DM * 2), pg8::pack8(s0 * inv - a, s1 * inv - b));
        f32x4 oa, ob; pg8::unpack8(xr[i], oa, ob); s0 -= oa; s1 -= ob; }
    asm volatile("" ::: "memory");
}
template <int W>
__device__ __forceinline__ void ew_quarter_t(int pm, int g, int tid, const unsigned char* ws) {
    const int cvq = tid & 31, sA = tid >> 5, ch = 256 * g + 8 * cvq;
    for (int h = 0; h < 2; ++h) ew_strip<W>(pm * 256 + 8 * (sA + 16 * h), ch, ws);
}
__device__ __forceinline__ void conv_fixup(int pm, int g, int tid, const unsigned char* ws, bf16* AB) {
    if (pm >= MP / 256 || (pm & 7) == 0 || tid >= 128) return;
    const int k = tid >> 6, ch = 256 * g + 4 * (tid & 63);
    const float* cw = (const float*)(ws + WS_CW) + ch; const float* sp = (const float*)(ws + WS_SIDE) + (size_t)(pm - 1) * 6 * DM + ch; const float* sc = (const float*)(ws + WS_SIDE) + (size_t)pm * 6 * DM + ch;
    const f32x4 w0 = *(const f32x4*)cw, w1 = *(const f32x4*)(cw + DM), w2 = *(const f32x4*)(cw + 2 * DM), cb = *(const f32x4*)(cw + 3 * DM);
    const f32x4 l0 = *(const f32x4*)sp, l1 = *(const f32x4*)(sp + DM), f0 = *(const f32x4*)(sc + 2 * DM), f1 = *(const f32x4*)(sc + 3 * DM), q = *(const f32x4*)(sc + (4 + k) * DM);
    const f32x4 um2 = k == 0 ? l0 : l1, um1 = k == 0 ? l1 : f0, uu = k == 0 ? f0 : f1;
    *(pg8::u32x2*)(AB + (size_t)(pm * 256 + k) * (2 * DM) + ch) = pg8::pack4(q * (cb + w0 * um2 + w1 * um1 + w2 * uu));
}
__device__ __forceinline__ void ew_quarter(int pm, int g, int tid, const unsigned char* ws, bf16* AB) {
    switch (g) {
        case 0: ew_quarter_t<2>(pm, g, tid, ws); break;
        case 1: ew_quarter_t<4>(pm, g, tid, ws); break;
        case 2: ew_quarter_t<8>(pm, g, tid, ws); break;
        default: ew_quarter_t<16>(pm, g, tid, ws); break;
    }
    conv_fixup(pm, g, tid, ws, AB);
}

typedef const __attribute__((address_space(4))) unsigned long long* kargp_t;
__device__ __forceinline__ unsigned long long karg64(int idx) { kargp_t kp = (kargp_t)__builtin_amdgcn_kernarg_segment_ptr(); asm volatile("" : "+s"(kp)); return kp[idx]; }
#define KIN(k) ((const float*)karg64(k))
#define KOUT() ((float*)karg64(18))
#define KWS() ((unsigned char*)karg64(19))

__global__ void __launch_bounds__(NWAVES * 64, 2) fwd_mega(Args args) {
    extern __shared__ __attribute__((aligned(16))) unsigned char lds_raw[];
    LAS unsigned char* lds = (LAS unsigned char*)lds_raw;
    volatile LAS unsigned* MISC = (volatile LAS unsigned*)(lds + MISC_OFF);
    const int wave = __builtin_amdgcn_readfirstlane((int)threadIdx.x >> 6);
#define LANE_ID() lane_id_opaque()
#define TID() (wave * 64 + LANE_ID())
    const int G = gridDim.x; const int bx = blockIdx.x; const int vcu = (G % 8 == 0) ? (bx % 8) * (G / 8) + bx / 8 : bx;
    (void)args;

    for (int u = TID(); u < (LDS_BYTES - XL_OFF) / 4; u += NWAVES * 64) ((LAS unsigned*)(lds + XL_OFF))[u] = 0u;
    __syncthreads();
    { const XcdBarrier b0 = xcd_barrier_post((unsigned*)(KWS() + WS_CTL) + CW_BAR, MISC + 8, wave); if (TID() == 0) { MISC[10] = b0.x; __hip_atomic_fetch_or((unsigned*)(KWS() + WS_CTL) + CW_TMASK + (vcu >> 2), 1u << b0.x, __ATOMIC_RELAXED, __HIP_MEMORY_SCOPE_AGENT);
        __hip_atomic_fetch_or((unsigned*)(KWS() + WS_CTL) + CW_GMASK + (bx & 7), 1u << b0.x, __ATOMIC_RELAXED, __HIP_MEMORY_SCOPE_AGENT); } }
    __syncthreads();
#define GRID_BAR() do { XcdBarrier b_; b_.bar = (unsigned*)(KWS() + WS_CTL) + CW_BAR; b_.st = MISC + 8; b_.x = (unsigned)__builtin_amdgcn_readfirstlane((int)MISC[10]); xcd_barrier(b_, wave); } while (0)
    LAS unsigned char* xl = lds + XL_OFF;
    const int NG1 = G - NCH;
    const bool chain = bx >= NG1; const int ci = bx - NG1;

    {
        unsigned char* ws = KWS();
        const float *x_p = KIN(0), *x_s = KIN(1), *p_p = KIN(2), *p_s = KIN(3), *g_pre = KIN(6), *w_in = KIN(7), *w_grp = KIN(10), *w_a = KIN(12), *w_b = KIN(13), *w_o = KIN(14), *w_ple = KIN(16), *w_pg = KIN(17);
        bf16 *BT1 = (bf16*)(ws + WS_BT1), *WG = (bf16*)(ws + WS_WG), *WAB = (bf16*)(ws + WS_WAB), *WO = (bf16*)(ws + WS_WO), *WPP = (bf16*)(ws + WS_WPP), *XP = (bf16*)(ws + WS_XP), *H = (bf16*)(ws + WS_H);
        const int lane = LANE_ID();
        LAS float* scr = (LAS float*)(lds + wave * 16384);
        const int gw = vcu * NWAVES + wave, NGW = G * NWAVES;
        constexpr int I_IN = 16 * 256, I_SQ = 16 * 32, I_PLE = 4 * 32, I_G = 4 * 4 * 8, NITEMS = I_IN + 4 * I_SQ + I_PLE + I_G;
        for (int it = gw; it < NITEMS; it += NGW) {
            int r = it;
            if (r < I_IN) { const int kb = r / 256, nb = r % 256; p0_transpose_item<true>(w_in, NIN, BT1, DM, 0, 0, scr, kb, nb, lane); continue; } r -= I_IN;
            if (r < I_SQ) { p0_transpose_item<false>(w_a, DM, WAB, 2 * DM, 0, 0, scr, r / 32, r % 32, lane); continue; } r -= I_SQ;
            if (r < I_SQ) { p0_transpose_item<false>(w_b, DM, WAB, 2 * DM, DM, 0, scr, r / 32, r % 32, lane); continue; } r -= I_SQ;
            if (r < I_SQ) { p0_transpose_item<false>(w_o, DM, WO, DM, 0, 0, scr, r / 32, r % 32, lane); continue; } r -= I_SQ;
            if (r < I_SQ) { p0_transpose_item<false>(w_pg, DM, WPP, XPLD, 0, 0, scr, r / 32, r % 32, lane); continue; } r -= I_SQ;
            if (r < I_PLE) { p0_transpose_item<false>(w_ple, DM, WPP, XPLD, DM, 0, scr, r / 32, r % 32, lane); continue; } r -= I_PLE;
            { const int g = r / 32, q = r % 32; p0_transpose_item<false>(w_grp + (size_t)g * 256 * 256, 256, WG + (size_t)g * 256 * 256, 256, 0, 0, scr, q / 8, q % 8, lane); }
        }
        f32x4 gv[2][2];
#pragma unroll
        for (int j = 0; j < 2; ++j) { gv[j][0] = ((const GAS f32x4*)(g_pre + 512 * j))[2 * lane]; gv[j][1] = ((const GAS f32x4*)(g_pre + 512 * j))[2 * lane + 1]; }
        for (int m4 = gw; m4 < M / 4; m4 += NGW) {
            const int m = 4 * m4;
            const float* xrow = m < MP ? x_p + (size_t)m * DM : x_s + (size_t)(m - MP) * DM;
            const float* prow = m < MP ? p_p + (size_t)m * PLE : p_s + (size_t)(m - MP) * PLE;
            f32x4 v[4][2][2], pv[4];
#pragma unroll
            for (int r = 0; r < 4; ++r) {
#pragma unroll
                for (int j = 0; j < 2; ++j) { v[r][j][0] = __builtin_nontemporal_load((const GAS f32x4*)(xrow + (size_t)r * DM + 512 * j) + 2 * lane); v[r][j][1] = __builtin_nontemporal_load((const GAS f32x4*)(xrow + (size_t)r * DM + 512 * j) + 2 * lane + 1); }
                pv[r] = __builtin_nontemporal_load((const GAS f32x4*)(prow + (size_t)r * PLE) + lane); }
            __builtin_amdgcn_sched_barrier(0);
#pragma unroll
            for (int r = 0; r < 4; ++r) { float s = 0.f;
#pragma unroll
                for (int j = 0; j < 2; ++j)
#pragma unroll
                    for (int q = 0; q < 2; ++q) { const f32x4 t = v[r][j][q]; s += (t.x * t.x + t.y * t.y) + (t.z * t.z + t.w * t.w); }
                const float rstd = 1.f / sqrtf(wave_sum(s) * (1.f / DM) + EPS);
#pragma unroll
                for (int j = 0; j < 2; ++j) { const f32x4 y0 = v[r][j][0] * rstd * gv[j][0], y1 = v[r][j][1] * rstd * gv[j][1];
                    v4u o; o.x = pk2(y0.x, y0.y); o.y = pk2(y0.z, y0.w); o.z = pk2(y1.x, y1.y); o.w = pk2(y1.z, y1.w);
                    ((GAS v4u*)(H + (size_t)(m + r) * DM + 512 * j))[lane] = o; }
                ((GAS unsigned long long*)(XP + (size_t)(m + r) * XPLD + DM))[lane] = (unsigned long long)pk2(pv[r].x, pv[r].y) | ((unsigned long long)pk2(pv[r].z, pv[r].w) << 32); }
        }
        { const float *state_pool = KIN(5), *cache_conv = KIN(4); bf16 *HP = (bf16*)(ws + WS_HP), *HC = (bf16*)(ws + WS_HC);
          const int gt = gw * 64 + lane, NT = NGW * 64; constexpr int NP8 = DB * 15 * DM / 8, NC8 = DB * 2 * DM / 8;
          for (int i = gt; i < NP8 + NC8; i += NT) { const bool isp = i < NP8; const int k = isp ? i : i - NP8; const float* src = (isp ? state_pool : cache_conv) + (size_t)k * 8;
              const f32x4 a = *(const GAS f32x4*)src, b = *(const GAS f32x4*)(src + 4); v4u o; o.x = pk2(a.x, a.y); o.y = pk2(a.z, a.w); o.z = pk2(b.x, b.y); o.w = pk2(b.z, b.w);
              *(GAS v4u*)((isp ? HP : HC) + (size_t)k * 8) = o; }
          { const float *conv_w = KIN(8), *conv_b = KIN(9); float* cwd = (float*)(ws + WS_CW);
            for (int i = gt; i < 4 * DM / 4; i += NT) ((GAS f32x4*)cwd)[i] = i < 3 * DM / 4 ? ((const GAS f32x4*)conv_w)[i] : ((const GAS f32x4*)conv_b)[i - 3 * DM / 4]; } }
        VM_WAIT(); __syncthreads();
        GRID_BAR();
    }

    for (int part = 0; part < 2; ++part) {
        if (part == 0 || !chain) {
            unsigned char* ws = KWS(); float* out = KOUT();
            pg8::EpiG1 E1{ws, out};
            const pg8::Gemm g1{(bf16*)(ws + WS_H), (bf16*)(ws + WS_BT1), DM, DM, 0, 16, 16, 0, 0, 0, 0};
            pg8::G1Order S{part == 0 ? 0 : G, part == 0 ? G : NG1, bx, part == 0 ? 1 : (1 << 20)};
            pg8::gemm_phase<pg8::EpiG1, pg8::G1Order>(lds, xl, wave, g1, S, E1);
        }
        if (part == 0) GRID_BAR();
    }

    unsigned lb_epoch = 0, tb_epoch = 0;
    for (int rnd = 0; rnd < 2; ++rnd) {
        const bool act = (rnd == 1) || chain;
        const int first = rnd == 0 ? 256 + ci : vcu, stride = rnd == 0 ? 1 : G, count = rnd == 0 ? 1 : (256 - vcu + G - 1) / G;
#define STAGE_BAR() do { if (rnd == 1) { if (G == 256) { ++tb_epoch; unsigned* ctl_ = (unsigned*)(KWS() + WS_CTL); const unsigned tm_ = xb_ld(ctl_ + CW_TMASK + (vcu >> 2)); team_barrier(ctl_ + CW_TEAM + 64 * (vcu >> 2), 4u * tb_epoch, (tm_ & (tm_ - 1u)) == 0u, ctl_ + CW_TMO, wave); } else GRID_BAR(); } else if (chain) { ++lb_epoch; unsigned* ctl_ = (unsigned*)(KWS() + WS_CTL); team_barrier(ctl_ + CW_TEAM + 64 * (64 + (ci >> 2)), 4u * lb_epoch, false, ctl_ + CW_TMO, wave); } } while (0)
        if (act) {
            unsigned char* ws = KWS(); bf16* AB = (bf16*)KOUT();
            { int tid_e = TID(); asm volatile("" : "+v"(tid_e));
              for (int j = 0; j < count; ++j) { const int L = first + j * stride; ew_quarter(L >> 2, L & 3, tid_e, ws, AB); } }
            VM_WAIT(); __syncthreads();
            if (TID() == 0) { __builtin_amdgcn_fence(__ATOMIC_ACQUIRE, "agent"); VM_WAIT(); }
            __syncthreads();
            const pg8::Gemm g{(bf16*)(ws + WS_H), (bf16*)(ws + WS_WG), DM, 256, 256, 4, 4, 0, 0, 0, 0}; pg8::ListOrder S{first, stride, count, 1};
            pg8::EpiG2 E{AB + DM, KIN(11)};
            pg8::gemm_phase<pg8::EpiG2, pg8::ListOrder>(lds, xl, wave, g, S, E);
        } STAGE_BAR();
        if (act) {
            unsigned char* ws = KWS(); bf16* AB = (bf16*)KOUT();
            const pg8::Gemm g{AB, (bf16*)(ws + WS_WAB), 2 * DM, 2 * DM, 0, 16, 16, 0, DM, 0, DM}; pg8::ListOrder S{first, stride, count, 2};
            pg8::EpiG34 E{(bf16*)(ws + WS_R), (bf16*)(ws + WS_SGB), (bf16*)(ws + WS_H)};
            pg8::gemm_phase<pg8::EpiG34, pg8::ListOrder>(lds, xl, wave, g, S, E);
        } STAGE_BAR();
        if (act) {
            unsigned char* ws = KWS(); unsigned* ctl_ = (unsigned*)(ws + WS_CTL);
            const pg8::Gemm g{(bf16*)(ws + WS_H), (bf16*)(ws + WS_WO), DM, DM, 0, 16, 16, 0, 0, 0, 0}; pg8::ListOrder S{first, stride, count, 1};
            pg8::EpiG5 E{KIN(0), KIN(1), KIN(15), KOUT() + OUT_Y, (bf16*)(ws + WS_XP), (float*)(ws + WS_SLOT), ctl_ + CW_SEAM, ctl_ + CW_TMO};
            pg8::gemm_phase<pg8::EpiG5, pg8::ListOrder>(lds, xl, wave, g, S, E);
        } STAGE_BAR();
        if (act) {
            unsigned char* ws = KWS();
            const pg8::Gemm g{(bf16*)(ws + WS_XP), (bf16*)(ws + WS_WPP), XPLD, XPLD, 0, 4, 16, DM, 0, DM, 0}; pg8::ListOrder S{first, stride, count, 2};
            pg8::EpiG6 E{KOUT() + OUT_Y, (bf16*)(ws + WS_H), (const bf16*)(ws + WS_XP)};
            pg8::gemm_phase<pg8::EpiG6, pg8::ListOrder>(lds, xl, wave, g, S, E);
        }
        if (rnd == 0) {
            if (G == 256) { unsigned* ctl_ = (unsigned*)(KWS() + WS_CTL); const unsigned gm_ = xb_ld(ctl_ + CW_GMASK + (bx & 7)); team_barrier(ctl_ + CW_GRP + 64 * (bx & 7), 32u, (gm_ & (gm_ - 1u)) == 0u, ctl_ + CW_TMO, wave); }
            else GRID_BAR(); }
#undef STAGE_BAR
    }
}

extern "C" void kernel_launch(void* const* d_in, const int* in_sizes, int n_in, void* d_out, int out_size, void* d_ws, size_t ws_size, hipStream_t stream) {
    static int grid = 0;
    if (grid == 0) {
        if (n_in != 18 || in_sizes[0] != MP * DM || (size_t)out_size != OUT_END || ws_size < WS_END) {
            fprintf(stderr, "kernel_launch: unexpected shapes: n_in %d in0 %d out %d ws %zu (need >= %zu)\n", n_in, n_in > 0 ? in_sizes[0] : -1, out_size, ws_size, (size_t)WS_END); grid = -1; return; }
        int dev = 0, cus = 0, per_cu = 0;
        if (hipGetDevice(&dev) != hipSuccess || hipDeviceGetAttribute(&cus, hipDeviceAttributeMultiprocessorCount, dev) != hipSuccess) { grid = -1; return; }
        if (hipFuncSetAttribute((const void*)fwd_mega, hipFuncAttributeMaxDynamicSharedMemorySize, LDS_BYTES) != hipSuccess) { fprintf(stderr, "kernel_launch: hipFuncSetAttribute failed\n"); grid = -1; return; }
        if (hipOccupancyMaxActiveBlocksPerMultiprocessor(&per_cu, (const void*)fwd_mega, NWAVES * 64, LDS_BYTES) != hipSuccess || per_cu < 1)
            fprintf(stderr, "kernel_launch: note: occupancy query reports %d workgroups per CU\n", per_cu);
        (void)hipGetLastError();
        grid = cus;
        if (grid % 8 != 0) grid -= grid % 8;
        if (grid < 64) { fprintf(stderr, "kernel_launch: only %d CUs\n", cus); grid = -1; return; }
    }
    if (grid < 0) return;
    if (hipMemsetAsync((char*)d_ws + WS_CTL, 0, CTL_ZERO_BYTES, stream) != hipSuccess) { fprintf(stderr, "kernel_launch: memset failed\n"); return; }
    Args a{};
    for (int i = 0; i < 18; ++i) a.in[i] = (const float*)d_in[i];
    a.out = (float*)d_out; a.ws = (unsigned char*)d_ws;
    hipLaunchKernelGGL(fwd_mega, dim3(grid), dim3(NWAVES * 64), LDS_BYTES, stream, a);
}
```
